# Optimizing an MI355X kernel written in HIP

```python
import jax, jax.numpy as jnp
from jax import lax
import numpy as np

D_MODEL = 1024
BATCH = 16
SEQ = 4096
DEPTH = 1

HEAD_DIM = 64
BRANCH_WIDTH = D_MODEL // 2
A_GROUPS = ((128, 1), (512, 4), (2048, 16))
A_HEADS = BRANCH_WIDTH // HEAD_DIM
B_HEADS = BRANCH_WIDTH // HEAD_DIM
B_KV_HEADS = B_HEADS // 4
M_HEADS = 4
M_HEAD_DIM = BRANCH_WIDTH // M_HEADS
N_MEM = 256
GRID_W = 64
ROPE_THETA = 10000.0
Q_BLOCK = 128
NORM_EPS = 1e-6
NEG_INF = -1e30
N_BRANCHES = 3

A_QKV = 3 * len(A_GROUPS) * A_HEADS * HEAD_DIM
B_Q = B_HEADS * HEAD_DIM
B_KV = B_KV_HEADS * HEAD_DIM
M_Q = M_HEADS * M_HEAD_DIM
SPLIT_SIZES = (A_QKV, B_Q, B_KV, B_KV, M_Q, BRANCH_WIDTH, BRANCH_WIDTH, BRANCH_WIDTH, N_BRANCHES * D_MODEL)
IN_WIDTH = A_QKV + B_Q + 2 * B_KV + M_Q + 3 * BRANCH_WIDTH + N_BRANCHES * D_MODEL

kernel_name = 'hybrid_dilated_axial_memory_block'


def rms_norm(x, g):
    xf = x.astype(jnp.float32)
    y = xf * lax.rsqrt(jnp.mean(xf * xf, axis=-1, keepdims=True) + NORM_EPS)
    return (y * g.astype(jnp.float32)).astype(x.dtype)


def rope(x, pos):
    dr = x.shape[-1]
    half = dr // 2
    inv = jnp.power(ROPE_THETA, -jnp.arange(half, dtype=jnp.float32) * 2.0 / dr)
    ang = pos.astype(jnp.float32)[:, None] * inv[None, :]
    cos = jnp.cos(ang)[:, None, :]
    sin = jnp.sin(ang)[:, None, :]
    xf = x.astype(jnp.float32)
    x1, x2 = xf[..., :half], xf[..., half:]
    return jnp.concatenate([x1 * cos - x2 * sin, x1 * sin + x2 * cos], axis=-1).astype(x.dtype)


def axial_rope(x, row_pos, col_pos):
    half = x.shape[-1] // 2
    return jnp.concatenate([rope(x[..., :half], row_pos), rope(x[..., half:], col_pos)], axis=-1)


def dilated_window_attention(q, k, v, window, dilation):
    b, s, h, dh = q.shape
    half = window // (2 * dilation)
    blk = half
    L = s // dilation
    nb = -(-L // blk)
    lp = nb * blk
    z = b * dilation

    def regroup(t):
        return t.reshape(b, L, dilation, h, dh).transpose(0, 2, 1, 3, 4).reshape(z, L, h, dh)

    qg, kg, vg = regroup(q), regroup(k), regroup(v)
    qb = jnp.pad(qg, ((0, 0), (0, lp - L), (0, 0), (0, 0))).reshape(z, nb, blk, h, dh)

    def band(t):
        tp = jnp.pad(t, ((0, 0), (blk, lp - L + blk), (0, 0), (0, 0))).reshape(z, nb + 2, blk, h, dh)
        return jnp.concatenate([tp[:, :-2], tp[:, 1:-1], tp[:, 2:]], axis=2)

    kw, vw = band(kg), band(vg)
    qpos = jnp.arange(nb)[:, None] * blk + jnp.arange(blk)[None, :]
    kpos = (jnp.arange(nb)[:, None] - 1) * blk + jnp.arange(3 * blk)[None, :]
    valid = ((jnp.abs(qpos[:, :, None] - kpos[:, None, :]) <= half)
             & (kpos[:, None, :] >= 0) & (kpos[:, None, :] < L))
    sc = jnp.einsum('znqhd,znkhd->znhqk', qb, kw).astype(jnp.float32) * (dh ** -0.5)
    sc = jnp.where(valid[None, :, None], sc, NEG_INF)
    m = jnp.max(sc, axis=-1, keepdims=True)
    p = jnp.exp(sc - m)
    l = jnp.sum(p, axis=-1, keepdims=True)
    o = jnp.einsum('znhqk,znkhd->znqhd', (p / l).astype(v.dtype), vw)
    lse = (m + jnp.log(l))[..., 0]
    o = o.reshape(b, dilation, lp, h, dh)[:, :, :L].transpose(0, 2, 1, 3, 4).reshape(b, s, h, dh)
    lse = lse.transpose(0, 1, 3, 2).reshape(b, dilation, lp, h)[:, :, :L]
    lse = lse.transpose(0, 2, 1, 3).reshape(b, s, h)
    return o, lse


def setup_inputs(seed: int = 0) -> dict:
    key = jax.random.key(seed)
    ks = jax.random.split(key, 16)
    nrm = jax.random.normal
    f32 = jnp.float32
    return {
        'x': nrm(ks[0], (BATCH, SEQ, D_MODEL), f32),
        'mem': nrm(ks[1], (BATCH, N_MEM, D_MODEL), f32),
        'g_pre': 1.0 + 0.05 * nrm(ks[2], (DEPTH, D_MODEL), f32),
        'w_in': nrm(ks[3], (DEPTH, D_MODEL, IN_WIDTH), f32) * D_MODEL ** -0.5,
        'b_merge': 0.1 * nrm(ks[4], (DEPTH, N_BRANCHES * D_MODEL), f32),
        'q_norm': 1.0 + 0.05 * nrm(ks[5], (DEPTH, HEAD_DIM), f32),
        'k_norm': 1.0 + 0.05 * nrm(ks[6], (DEPTH, HEAD_DIM), f32),
        'g_mem': 1.0 + 0.05 * nrm(ks[7], (DEPTH, D_MODEL), f32),
        'w_mem_kv': nrm(ks[8], (DEPTH, D_MODEL, 2 * M_Q), f32) * D_MODEL ** -0.5,
        'w_br_a': nrm(ks[9], (DEPTH, BRANCH_WIDTH, D_MODEL), f32) * BRANCH_WIDTH ** -0.5,
        'w_br_b': nrm(ks[10], (DEPTH, BRANCH_WIDTH, D_MODEL), f32) * BRANCH_WIDTH ** -0.5,
        'w_br_m': nrm(ks[11], (DEPTH, BRANCH_WIDTH, D_MODEL), f32) * BRANCH_WIDTH ** -0.5,
        'w_out': nrm(ks[12], (DEPTH, D_MODEL, D_MODEL), f32) * D_MODEL ** -0.5,
        'g_post': 1.0 + 0.05 * nrm(ks[13], (DEPTH, D_MODEL), f32),
    }


def reference(x, mem, g_pre, w_in, b_merge, q_norm, k_norm, g_mem, w_mem_kv, w_br_a, w_br_b, w_br_m, w_out, g_post):
    b, s, d = x.shape
    dt = x.dtype
    pos = jnp.arange(s, dtype=jnp.float32)
    rows = s // GRID_W
    row_pos = jnp.repeat(jnp.arange(rows, dtype=jnp.float32), GRID_W)
    col_pos = (jnp.arange(s) % GRID_W).astype(jnp.float32)
    split_at = np.cumsum(SPLIT_SIZES)[:-1].tolist()
    n_groups = len(A_GROUPS)
    kv_rep = B_HEADS // B_KV_HEADS
    n_q_blocks = s // Q_BLOCK

    for layer in range(DEPTH):
        h = rms_norm(x, g_pre[layer])
        a_qkv, bq, bk, bv, mq, ga, gb, gm, mg = jnp.split(h @ w_in[layer], split_at, axis=-1)

        a_qkv = a_qkv.reshape(b, s, 3, n_groups * A_HEADS, HEAD_DIM)
        aq = rope(a_qkv[:, :, 0], pos)
        ak = rope(a_qkv[:, :, 1], pos)
        av = a_qkv[:, :, 2]
        outs, lses = [], []
        for gi, (window, dil) in enumerate(A_GROUPS):
            hs = slice(gi * A_HEADS, (gi + 1) * A_HEADS)
            o_g, lse_g = dilated_window_attention(aq[:, :, hs], ak[:, :, hs], av[:, :, hs], window, dil)
            outs.append(o_g)
            lses.append(lse_g)
        wts = jax.nn.softmax(jnp.stack(lses, axis=0), axis=0).astype(dt)
        oa = jnp.einsum('gbsh,gbshd->bshd', wts, jnp.stack(outs, axis=0)).reshape(b, s, BRANCH_WIDTH)

        qb_ = axial_rope(rms_norm(bq.reshape(b, s, B_HEADS, HEAD_DIM), q_norm[layer]), row_pos, col_pos)
        kb_ = axial_rope(rms_norm(bk.reshape(b, s, B_KV_HEADS, HEAD_DIM), k_norm[layer]), row_pos, col_pos)
        vb_ = bv.reshape(b, s, B_KV_HEADS, HEAD_DIM)
        q_blocks = qb_.reshape(b, n_q_blocks, Q_BLOCK, B_KV_HEADS, kv_rep, HEAD_DIM).transpose(1, 0, 2, 3, 4, 5)

        def attend(qc, kb_=kb_, vb_=vb_):
            sc = jnp.einsum('bqkgd,bskd->bkgqs', qc, kb_).astype(jnp.float32) * (HEAD_DIM ** -0.5)
            p = jax.nn.softmax(sc, axis=-1).astype(vb_.dtype)
            return jnp.einsum('bkgqs,bskd->bqkgd', p, vb_)

        ob = lax.map(attend, q_blocks).transpose(1, 0, 2, 3, 4, 5).reshape(b, s, B_Q)

        kvm = rms_norm(mem, g_mem[layer]) @ w_mem_kv[layer]
        n_mem = mem.shape[1]
        km = kvm[..., :M_Q].reshape(b, n_mem, M_HEADS, M_HEAD_DIM)
        vm = kvm[..., M_Q:].reshape(b, n_mem, M_HEADS, M_HEAD_DIM)
        sm = jnp.einsum('bshd,bnhd->bhsn', mq.reshape(b, s, M_HEADS, M_HEAD_DIM), km).astype(jnp.float32)
        pm = jax.nn.softmax(sm * (M_HEAD_DIM ** -0.5), axis=-1).astype(dt)
        om = jnp.einsum('bhsn,bnhd->bshd', pm, vm).reshape(b, s, M_Q)

        ya = (oa * jax.nn.silu(ga)) @ w_br_a[layer]
        yb = (ob * jax.nn.silu(gb)) @ w_br_b[layer]
        ym = (om * jax.nn.silu(gm)) @ w_br_m[layer]
        gates = jax.nn.sigmoid((mg + b_merge[layer]).astype(jnp.float32)).astype(dt).reshape(b, s, N_BRANCHES, d)
        merged = gates[:, :, 0] * ya + gates[:, :, 1] * yb + gates[:, :, 2] * ym
        out = merged @ w_out[layer]
        x = x + rms_norm(out, g_post[layer])
    return x
```

```cpp
#include <hip/hip_runtime.h>
#include <hip/hip_cooperative_groups.h>
#include <hip/hip_bf16.h>
#include <cstdio>
#include <cstdint>
#include <cmath>
namespace cg = cooperative_groups;

#define LAS __attribute__((address_space(3)))
typedef unsigned short bf16_t;
typedef short bf16x8 __attribute__((ext_vector_type(8)));
typedef short s16x4 __attribute__((ext_vector_type(4)));
typedef float f32x2 __attribute__((ext_vector_type(2)));
typedef float f32x4 __attribute__((ext_vector_type(4)));
typedef float f32x16 __attribute__((ext_vector_type(16)));
typedef unsigned u32x2 __attribute__((ext_vector_type(2)));
typedef unsigned u32x4 __attribute__((ext_vector_type(4)));
typedef __bf16 bf16x2_t __attribute__((ext_vector_type(2)));

constexpr int BATCH = 16, SEQ = 4096, DM_ = 1024, MTOT = BATCH * SEQ;
constexpr int NCH = 2, BPC = BATCH / NCH, RC = BPC * SEQ;
constexpr int INW = 10496, PITCH = INW;
constexpr int C_AQ = 0, C_AK = 1536, C_AV = 3072, C_BQ = 4608, C_BK = 5120, C_BV = 5248, C_MQ = 5376, C_GA = 5888, C_GB = 6400, C_GM = 6912, C_MG = 7424;
constexpr int NMEM = 256;
constexpr size_t PTILE = (size_t)RC * 256;
__host__ __device__ __forceinline__ size_t pidx(size_t row, int col) { return (size_t)(col >> 8) * PTILE + row * 256 + (size_t)(col & 255); }
constexpr float LOG2E = 1.4426950408889634f;
constexpr float QS_A = 0.125f * LOG2E;
constexpr float QS_M = 0.08838834764831845f * LOG2E;
constexpr float NORM_EPS = 1e-6f;

__device__ __forceinline__ unsigned pk2(float lo, float hi) { f32x2 v = {lo, hi}; bf16x2_t b = __builtin_convertvector(v, bf16x2_t); return __builtin_bit_cast(unsigned, b); }
__device__ __forceinline__ float bflo(unsigned w) { return __uint_as_float(w << 16); }
__device__ __forceinline__ float bfhi(unsigned w) { return __uint_as_float(w & 0xffff0000u); }

namespace pg8 {
#define PG8_LAS __attribute__((address_space(3)))
constexpr int BM = 256, BK = 64, HALF = 128, HTB = HALF * BK * 2, STAGE_BYTES = 8 * HTB, NXCD = 8, WGM = 8;
__host__ __device__ __forceinline__ int lds_byte(int r, int c) { const int st = (r >> 4) * 2 + (c >> 5), rr = r & 15, cc = c & 31, ob = rr * 64 + cc * 2; return st * 1024 + (ob ^ (((ob >> 9) & 1) << 5)); }
__host__ __device__ __forceinline__ void stage_rc(int b, int& R, int& C) { const int st = b / 1024, sb = b % 1024, swz = sb ^ (((sb >> 9) & 1) << 5); R = (st >> 1) * 16 + swz / 64; C = (st & 1) * 32 + (swz % 64) / 2; }

struct Unit { int pm, pn, kind; };
struct Sched {
    int nM, nN, nwg, nX, G, c, seg3;
    const char *A, *B, *A2, *B2; size_t tsA, tsB, grpStride; int grpShift;
    __device__ __forceinline__ bool next(int i, Unit& u) const {
        const int seg = seg3 ? i % 3 : 0; if (seg3) i /= 3;
        int L = i * G + c; asm volatile("" : "+s"(L)); if (L >= nwg + nX) return false;
        if (L >= nwg) { const int e = L - nwg; u.pm = e >> 2; u.pn = e & 3; u.kind = 1; return true; }
        int wgid = L; { const int q = nwg / NXCD, r = nwg % NXCD, xcd = wgid % NXCD, off = wgid / NXCD; wgid = (xcd < r ? xcd * (q + 1) : r * (q + 1) + (xcd - r) * q) + off; }
        const int nig = WGM * nN, gid = wgid / nig, fm = gid * WGM, gsz = (nM - fm) < WGM ? (nM - fm) : WGM;
        u.pm = fm + ((wgid % nig) % gsz); u.pn = (wgid % nig) / gsz + 4 * seg; u.kind = 0; return true;
    }
    __device__ __forceinline__ const char* aptr(const Unit& u) const { return u.kind ? A2 + (size_t)u.pm * tsA : A + (size_t)(u.pn >> grpShift) * grpStride + (size_t)u.pm * tsA; }
    __device__ __forceinline__ const char* bptr(const Unit& u) const { return (u.kind ? B2 : B) + (size_t)u.pn * tsB; }
};
template <class Epi, class Sched, bool ALIGN_EPI = false, bool SP2 = false>
__device__ __forceinline__ void gemm_phase(PG8_LAS unsigned char* lds, const int K, const Sched& S, const Epi& E) {
    int tid_ = threadIdx.x; asm volatile("" : "+v"(tid_)); const int tid = tid_, wid = __builtin_amdgcn_readfirstlane(tid >> 6), lane = tid & 63, wr = wid >> 2, wc = wid & 3, fr = lane & 15, fq = lane >> 4;
    const int nt = K / BK;
    unsigned voffA[2], voffB[2];
#pragma unroll
    for (int i = 0; i < 2; ++i) { int R, C; stage_rc(tid * 16 + i * 8192, R, C); const int Rb = R;
        voffA[i] = (unsigned)(R * K + C) * 2u; voffB[i] = (unsigned)(Rb * K + C) * 2u; }
    const size_t kstep = (size_t)(BK * 2);
    const size_t hstep = (size_t)HALF * K * 2;
    const unsigned ldsw = (unsigned)wid * 1024u;
    const int aoff = lds_byte(wr * 64 + fr, fq * 8), boff = lds_byte(wc * 32 + fr, fq * 8);
#define PG8_SA(b, h) (((b) * 2 + (h)) * HTB)
#define PG8_SB(b, h) ((4 + (b) * 2 + (h)) * HTB)
#define PG8_STAGE(bufoff, gbase, voff) do { _Pragma("unroll") for (int _i = 0; _i < 2; ++_i) \
        __builtin_amdgcn_global_load_lds((const unsigned*)((const char*)(gbase) + (voff)[_i]), (PG8_LAS unsigned*)(lds + (bufoff) + ldsw + _i * 8192), 16, 0, 0); } while (0)
#define PG8_LDA(dst, b, h) do { _Pragma("unroll") for (int m = 0; m < 4; ++m) _Pragma("unroll") for (int k = 0; k < 2; ++k) dst[m][k] = *(const PG8_LAS bf16x8*)(lds + PG8_SA(b, h) + aoff + m * 2048 + k * 1024); } while (0)
#define PG8_LDB(dst, b, h) do { _Pragma("unroll") for (int n = 0; n < 2; ++n) _Pragma("unroll") for (int k = 0; k < 2; ++k) dst[n][k] = *(const PG8_LAS bf16x8*)(lds + PG8_SB(b, h) + boff + n * 2048 + k * 1024); } while (0)
#define PG8_MMA(ai, bj, At, Bt) do { __builtin_amdgcn_s_setprio(1); _Pragma("unroll") for (int m = 0; m < 4; ++m) _Pragma("unroll") for (int n = 0; n < 2; ++n) _Pragma("unroll") for (int k = 0; k < 2; ++k) \
        acc[ai][bj][m][n] = __builtin_amdgcn_mfma_f32_16x16x32_bf16(Bt[n][k], At[m][k], acc[ai][bj][m][n], 0, 0, 0); __builtin_amdgcn_s_setprio(0); } while (0)
#define PG8_WAIT_V(n) asm volatile("s_waitcnt vmcnt(" #n ")" ::: "memory")
#define PG8_WAIT_L(n) asm volatile("s_waitcnt lgkmcnt(" #n ")" ::: "memory")
#define PG8_BAR __builtin_amdgcn_s_barrier()
#define PG8_SCHED __builtin_amdgcn_sched_barrier(0)
    Unit cur, nxt; int ui = 0;
    if (!S.next(0, cur)) return;
    f32x4 acc[2][2][4][2];
#pragma unroll
    for (int a = 0; a < 2; ++a)
#pragma unroll
        for (int b = 0; b < 2; ++b)
#pragma unroll
            for (int m = 0; m < 4; ++m)
#pragma unroll
                for (int n = 0; n < 2; ++n) acc[a][b][m][n] = (f32x4){0.f, 0.f, 0.f, 0.f};
    bf16x8 At[4][2], B0[2][2], B1[2][2];
    const char* cA = S.aptr(cur); const char* cB = S.bptr(cur);
    if constexpr (SP2) {
        PG8_STAGE(PG8_SB(0, 0), cB, voffB); PG8_STAGE(PG8_SB(0, 1), cB + hstep, voffB); PG8_STAGE(PG8_SA(0, 0), cA, voffA); PG8_STAGE(PG8_SA(0, 1), cA + hstep, voffA);
        if (wr == 1) PG8_BAR;
        PG8_WAIT_V(2); PG8_BAR;
        PG8_STAGE(PG8_SB(1, 0), cB + kstep, voffB); PG8_STAGE(PG8_SA(1, 0), cA + kstep, voffA); PG8_STAGE(PG8_SB(1, 1), cB + hstep + kstep, voffB);
        PG8_WAIT_V(6); PG8_BAR;
    } else {
        PG8_STAGE(PG8_SB(0, 0), cB, voffB); PG8_STAGE(PG8_SA(0, 0), cA, voffA); PG8_STAGE(PG8_SB(0, 1), cB + hstep, voffB); PG8_STAGE(PG8_SA(0, 1), cA + hstep, voffA);
        if (wr == 1) PG8_BAR;
        PG8_WAIT_V(4); PG8_BAR;
        PG8_STAGE(PG8_SB(1, 0), cB + kstep, voffB); PG8_STAGE(PG8_SA(1, 0), cA + kstep, voffA); PG8_STAGE(PG8_SB(1, 1), cB + hstep + kstep, voffB);
        PG8_WAIT_V(6); PG8_BAR;
    }
    for (;;) {
        const bool has_next = S.next(ui + 1, nxt);
        const char* nA = has_next ? S.aptr(nxt) : cA; const char* nB = has_next ? S.bptr(nxt) : cB;
        for (int t = 0; t < nt; t += 2) {
            const bool last = (t == nt - 2);
            const char* a1 = cA + (size_t)(t + 1) * kstep;
            const char* a2 = last ? nA : cA + (size_t)(t + 2) * kstep; const char* b2 = last ? nB : cB + (size_t)(t + 2) * kstep;
            const char* a3 = a2 + kstep; const char* b3 = b2 + kstep;
            if constexpr (SP2) {
            PG8_LDB(B0, 0, 0); PG8_LDB(B1, 0, 1); PG8_SCHED; PG8_LDA(At, 0, 0); PG8_STAGE(PG8_SA(1, 1), a1 + hstep, voffA);
            PG8_WAIT_V(8); PG8_WAIT_L(0); PG8_BAR; PG8_MMA(0, 0, At, B0); PG8_MMA(0, 1, At, B1); PG8_BAR; PG8_SCHED;
            PG8_LDA(At, 0, 1); PG8_STAGE(PG8_SB(0, 0), b2, voffB); PG8_STAGE(PG8_SB(0, 1), b2 + hstep, voffB); PG8_STAGE(PG8_SA(0, 0), a2, voffA);
            PG8_WAIT_V(8); PG8_WAIT_L(0); PG8_BAR; PG8_MMA(1, 0, At, B0); PG8_MMA(1, 1, At, B1); PG8_BAR; PG8_SCHED;
            PG8_LDB(B0, 1, 0); PG8_LDB(B1, 1, 1); PG8_SCHED; PG8_LDA(At, 1, 0); PG8_STAGE(PG8_SA(0, 1), a2 + hstep, voffA);
            PG8_WAIT_V(8); PG8_WAIT_L(0); PG8_BAR; PG8_MMA(0, 0, At, B0); PG8_MMA(0, 1, At, B1); PG8_BAR; PG8_SCHED;
            PG8_LDA(At, 1, 1); PG8_STAGE(PG8_SB(1, 0), b3, voffB); PG8_STAGE(PG8_SB(1, 1), b3 + hstep, voffB); PG8_STAGE(PG8_SA(1, 0), a3, voffA);
            PG8_WAIT_V(8); PG8_WAIT_L(0); PG8_BAR; PG8_MMA(1, 0, At, B0); PG8_MMA(1, 1, At, B1); PG8_BAR; PG8_SCHED;
            } else {
            PG8_LDB(B0, 0, 0); PG8_SCHED; PG8_LDA(At, 0, 0); PG8_STAGE(PG8_SA(1, 1), a1 + hstep, voffA);
            PG8_WAIT_L(8); PG8_BAR; PG8_WAIT_L(0); PG8_MMA(0, 0, At, B0); PG8_BAR; PG8_SCHED;
            PG8_LDB(B1, 0, 1); PG8_STAGE(PG8_SB(0, 0), b2, voffB);
            PG8_BAR; PG8_WAIT_L(0); PG8_MMA(0, 1, At, B1); PG8_BAR;
            PG8_LDA(At, 0, 1); PG8_STAGE(PG8_SA(0, 0), a2, voffA);
            PG8_BAR; PG8_WAIT_L(0); PG8_MMA(1, 0, At, B0); PG8_BAR; PG8_SCHED;
            PG8_STAGE(PG8_SB(0, 1), b2 + hstep, voffB);
            PG8_WAIT_V(6); PG8_BAR; PG8_MMA(1, 1, At, B1); PG8_BAR;
            PG8_LDB(B0, 1, 0); PG8_SCHED; PG8_LDA(At, 1, 0); PG8_STAGE(PG8_SA(0, 1), a2 + hstep, voffA);
            PG8_WAIT_L(8); PG8_BAR; PG8_WAIT_L(0); PG8_MMA(0, 0, At, B0); PG8_BAR; PG8_SCHED;
            PG8_LDB(B1, 1, 1); PG8_STAGE(PG8_SB(1, 0), b3, voffB);
            PG8_BAR; PG8_WAIT_L(0); PG8_MMA(0, 1, At, B1); PG8_BAR;
            PG8_LDA(At, 1, 1); PG8_STAGE(PG8_SA(1, 0), a3, voffA);
            PG8_BAR; PG8_WAIT_L(0); PG8_MMA(1, 0, At, B0); PG8_BAR; PG8_SCHED;
            PG8_STAGE(PG8_SB(1, 1), b3 + hstep, voffB);
            PG8_WAIT_V(6); PG8_BAR; PG8_MMA(1, 1, At, B1); PG8_BAR;
            }
        }
        if constexpr (ALIGN_EPI) { if (wr == 0) PG8_BAR; }
        { E(acc, cur, wr, wc, fr, fq); }
        if (!has_next) break;
#pragma unroll
        for (int a = 0; a < 2; ++a)
#pragma unroll
            for (int b = 0; b < 2; ++b)
#pragma unroll
                for (int m = 0; m < 4; ++m)
#pragma unroll
                    for (int n = 0; n < 2; ++n) acc[a][b][m][n] = (f32x4){0.f, 0.f, 0.f, 0.f};
        cur = nxt; cA = nA; cB = nB; ++ui;
        if constexpr (ALIGN_EPI) { if (wr == 1) PG8_BAR; }
    }
    PG8_WAIT_V(0);
    if constexpr (!ALIGN_EPI) { if (wr == 0) PG8_BAR; }
    PG8_BAR;
#undef PG8_SA
#undef PG8_SB
#undef PG8_STAGE
#undef PG8_LDA
#undef PG8_LDB
#undef PG8_MMA
#undef PG8_WAIT_V
#undef PG8_WAIT_L
#undef PG8_BAR
#undef PG8_SCHED
}
__device__ __forceinline__ u32x4 pack8(const f32x4 a, const f32x4 b) { u32x4 w; w.x = pk2(a[0], a[1]); w.y = pk2(a[2], a[3]); w.z = pk2(b[0], b[1]); w.w = pk2(b[2], b[3]); return w; }
__device__ __forceinline__ u32x4 xor1(u32x4 v) {
    u32x4 r;
#pragma unroll
    for (int e = 0; e < 4; ++e) r[e] = (unsigned)__builtin_amdgcn_mov_dpp((int)v[e], 0xB1, 0xF, 0xF, true);
    return r;
}
template <int PITCH_ = 256, bool NT = true>
__device__ __forceinline__ void store_pair(bf16_t* rp, int fr, const u32x4 wA, const u32x4 wB) {
    const bool odd = fr & 1;
    const u32x4 t = odd ? wA : wB, r = xor1(t);
    const u32x4 s1 = odd ? r : wA, s2 = odd ? wB : r;
    bf16_t* p1 = rp + (odd ? -PITCH_ + 32 : 0); bf16_t* p2 = rp + (odd ? 32 : PITCH_);
    if (NT) { __builtin_nontemporal_store(s1, (u32x4*)p1); __builtin_nontemporal_store(s2, (u32x4*)p2); } else { *(u32x4*)p1 = s1; *(u32x4*)p2 = s2; }
}
template <int PITCH_>
__device__ __forceinline__ void load_pair(const bf16_t* rp, int fr, u32x4& wA, u32x4& wB) {
    const bool odd = fr & 1;
    const u32x4 l1 = *(const u32x4*)(rp + (odd ? -PITCH_ + 32 : 0)), l2 = *(const u32x4*)(rp + (odd ? 32 : PITCH_));
    const u32x4 t = odd ? l1 : l2, r = xor1(t);
    wA = odd ? r : l1; wB = odd ? l2 : r;
}
__device__ __forceinline__ void store8(bf16_t* p, const f32x4 a, const f32x4 b) {
    u32x4 w; w.x = pk2(a[0], a[1]); w.y = pk2(a[2], a[3]); w.z = pk2(b[0], b[1]); w.w = pk2(b[2], b[3]); __builtin_nontemporal_store(w, (u32x4*)p);
}
constexpr size_t EP_COSA = (size_t)1 << 20, EP_SINA = EP_COSA + 512 * 1024, EP_COSB = (size_t)2 << 20, EP_SINB = EP_COSB + 4096, EP_KVM = (size_t)11 << 20;
constexpr size_t EP_P = ((size_t)52 << 20) + (size_t)3 * RC * 512 * 2 + (size_t)RC * 3072 * 2;
struct EpiP1 {
    unsigned char* ws; const float* bmerge; const float* qn; const float* kn;
    __device__ __forceinline__ void operator()(const f32x4 (&acc)[2][2][4][2], const Unit& u, int wr, int wc, int fr, int fq) const {
        asm volatile("" : "+v"(fr), "+v"(fq));
        float one = 1.f; asm volatile("" : "+v"(one));
        bf16_t* const P = (bf16_t*)(ws + EP_P); bf16_t* const KVM = (bf16_t*)(ws + EP_KVM);
        const float* const cosA = (const float*)(ws + EP_COSA); const float* const sinA = (const float*)(ws + EP_SINA); const float* const cosB = (const float*)(ws + EP_COSB); const float* const sinB = (const float*)(ws + EP_SINB);
        const int row0 = u.pm * BM + wr * 64 + fr;
        if (u.kind) {
            const int col = u.pn * BM + wc * 64 + fq * 8;
#pragma unroll
            for (int ai = 0; ai < 2; ++ai)
#pragma unroll
                for (int m = 0; m < 4; ++m) { bf16_t* rp = KVM + (size_t)(row0 + ai * HALF + m * 16) * 1024 + col;
#pragma unroll
                    for (int bj = 0; bj < 2; ++bj) store8(rp + bj * 32, acc[ai][bj][m][0], acc[ai][bj][m][1]); }
            return;
        }
        const int pn = u.pn, col = pn * BM + wc * 64 + fq * 8;
        int type;
        if (pn < 12) type = 0; else if (pn < 18) type = 1; else if (pn < 20) type = 2; else if (pn == 20) type = (wc < 2) ? 3 : 1;
        else if (pn < 23) type = 4; else if (pn < 29) type = 5; else type = 6;
        if (type == 0) {
            const float sc = ((pn < 6) ? QS_A : 1.f) * one;
#pragma unroll
            for (int ai = 0; ai < 2; ++ai) {
                f32x4 c0[4], c1[4], s0[4], s1[4];
#pragma unroll
                for (int m = 0; m < 4; ++m) { const int t = (row0 + ai * HALF + m * 16) & (SEQ - 1); const float* cp = cosA + t * 32 + fq * 8; const float* sp = sinA + t * 32 + fq * 8;
                    c0[m] = *(const f32x4*)cp; c1[m] = *(const f32x4*)(cp + 4); s0[m] = *(const f32x4*)sp; s1[m] = *(const f32x4*)(sp + 4); }
#pragma unroll
                for (int m = 0; m < 4; ++m) { const int row = row0 + ai * HALF + m * 16;
                    const f32x4 xa0 = acc[ai][0][m][0], xa1 = acc[ai][0][m][1], xb0 = acc[ai][1][m][0], xb1 = acc[ai][1][m][1];
                    const f32x4 ya0 = (xa0 * c0[m] - xb0 * s0[m]) * sc, ya1 = (xa1 * c1[m] - xb1 * s1[m]) * sc, yb0 = (xa0 * s0[m] + xb0 * c0[m]) * sc, yb1 = (xa1 * s1[m] + xb1 * c1[m]) * sc;
                    bf16_t* rp = P + pidx(row, col); store_pair(rp, fr, pack8(ya0, ya1), pack8(yb0, yb1)); }
            }
        } else if (type == 2 || type == 3) {
            const float* nw = (type == 2) ? qn : kn; const float sc = ((type == 2) ? QS_A : 1.f) * one; const float sg = (fq < 2) ? -1.f : 1.f; const int ib = (fq & 1) * 8;
            const f32x4 w00 = *(const f32x4*)(nw + fq * 8), w01 = *(const f32x4*)(nw + fq * 8 + 4), w10 = *(const f32x4*)(nw + 32 + fq * 8), w11 = *(const f32x4*)(nw + 32 + fq * 8 + 4);
#pragma unroll
            for (int ai = 0; ai < 2; ++ai)
#pragma unroll
                for (int m = 0; m < 4; ++m) { const int row = row0 + ai * HALF + m * 16, t = row & (SEQ - 1);
                    f32x4 xa0 = acc[ai][0][m][0], xa1 = acc[ai][0][m][1], xb0 = acc[ai][1][m][0], xb1 = acc[ai][1][m][1];
                    const f32x4 q2 = xa0 * xa0 + xa1 * xa1 + xb0 * xb0 + xb1 * xb1; float ss = (q2[0] + q2[1]) + (q2[2] + q2[3]);
                    ss += __shfl_xor(ss, 16); ss += __shfl_xor(ss, 32);
                    const float rstd = rsqrtf(ss * (one * (1.f / 64.f)) + NORM_EPS);
                    xa0 = xa0 * rstd * w00; xa1 = xa1 * rstd * w01; xb0 = xb0 * rstd * w10; xb1 = xb1 * rstd * w11;
                    const int pr = (t >> 6) * 16 + ib, pc = (t & 63) * 16 + ib;
                    const f32x4 cr0 = *(const f32x4*)(cosB + pr), cr1 = *(const f32x4*)(cosB + pr + 4), sr0 = *(const f32x4*)(sinB + pr), sr1 = *(const f32x4*)(sinB + pr + 4);
                    const f32x4 cc0 = *(const f32x4*)(cosB + pc), cc1 = *(const f32x4*)(cosB + pc + 4), sc0 = *(const f32x4*)(sinB + pc), sc1 = *(const f32x4*)(sinB + pc + 4);
                    f32x4 pa0, pa1, pb0, pb1;
#pragma unroll
                    for (int e = 0; e < 4; ++e) { pa0[e] = __shfl_xor(xa0[e], 32); pa1[e] = __shfl_xor(xa1[e], 32); pb0[e] = __shfl_xor(xb0[e], 32); pb1[e] = __shfl_xor(xb1[e], 32); }
                    const f32x4 ya0 = (xa0 * cr0 + pa0 * sr0 * sg) * sc, ya1 = (xa1 * cr1 + pa1 * sr1 * sg) * sc, yb0 = (xb0 * cc0 + pb0 * sc0 * sg) * sc, yb1 = (xb1 * cc1 + pb1 * sc1 * sg) * sc;
                    bf16_t* rp = P + pidx(row, col); store8(rp, ya0, ya1); store8(rp + 32, yb0, yb1); }
        } else if (type == 5) {
#pragma unroll
            for (int ai = 0; ai < 2; ++ai)
#pragma unroll
                for (int m = 0; m < 4; ++m) { bf16_t* rp = P + pidx(row0 + ai * HALF + m * 16, col);
                    u32x4 wv[2];
#pragma unroll
                    for (int bj = 0; bj < 2; ++bj) { f32x4 v0 = acc[ai][bj][m][0], v1 = acc[ai][bj][m][1];
#pragma unroll
                        for (int e = 0; e < 4; ++e) { v0[e] = v0[e] * __builtin_amdgcn_rcpf(1.f + __builtin_amdgcn_exp2f(-LOG2E * v0[e])); v1[e] = v1[e] * __builtin_amdgcn_rcpf(1.f + __builtin_amdgcn_exp2f(-LOG2E * v1[e])); }
                        wv[bj] = pack8(v0, v1); }
                    store_pair(rp, fr, wv[0], wv[1]); }
        } else if (type == 6) {
            const float* bp = bmerge + (pn * BM - C_MG) + wc * 64 + fq * 8;
            f32x4 b[2][2];
#pragma unroll
            for (int bj = 0; bj < 2; ++bj) { b[bj][0] = *(const f32x4*)(bp + 32 * bj); b[bj][1] = *(const f32x4*)(bp + 32 * bj + 4); }
            unsigned char* gbase = (unsigned char*)(P + (size_t)pn * PTILE) + (size_t)wc * ((size_t)RC * 64) + fq * 16;
#pragma unroll
            for (int ai = 0; ai < 2; ++ai)
#pragma unroll
                for (int m = 0; m < 4; ++m) { u32x4 w;
#pragma unroll
                    for (int bj = 0; bj < 2; ++bj)
#pragma unroll
                        for (int n = 0; n < 2; ++n) { const f32x4 v = acc[ai][bj][m][n] + b[bj][n]; unsigned r = 0u;
#pragma unroll
                            for (int e = 0; e < 4; ++e) { const float g = __builtin_amdgcn_rcpf(1.f + __builtin_amdgcn_exp2f(-LOG2E * v[e])); r = __builtin_amdgcn_cvt_pk_u8_f32(__builtin_rintf(g * 255.f), e, r); }
                            w[2 * bj + n] = r; }
                    __builtin_nontemporal_store(w, (u32x4*)(gbase + (size_t)(row0 + ai * HALF + m * 16) * 64)); }
        } else {
            const float sc = ((type == 4) ? QS_M : 1.f) * one;
#pragma unroll
            for (int ai = 0; ai < 2; ++ai)
#pragma unroll
                for (int m = 0; m < 4; ++m) { bf16_t* rp = P + pidx(row0 + ai * HALF + m * 16, col);
                    store_pair(rp, fr, pack8(acc[ai][0][m][0] * sc, acc[ai][0][m][1] * sc), pack8(acc[ai][1][m][0] * sc, acc[ai][1][m][1] * sc)); }
        }
    }
};
struct EpiBr {
    const bf16_t* __restrict__ P; bf16_t* Y;
    __device__ __forceinline__ void operator()(const f32x4 (&acc)[2][2][4][2], const Unit& u, int wr, int wc, int fr, int fq) const {
        asm volatile("" : "+v"(fr), "+v"(fq));
        const int row0 = u.pm * BM + wr * 64 + fr, colw = wc * 64 + fq * 8, ycol = (u.pn & 3) * BM + colw; const bool first = (u.pn < 4);
        const unsigned char* gbytes = (const unsigned char*)(P + (size_t)((C_MG >> 8) + u.pn) * PTILE) + (size_t)wc * ((size_t)RC * 64) + fq * 16;
        u32x4 g[2][4];
#pragma unroll
        for (int ai = 0; ai < 2; ++ai)
#pragma unroll
            for (int m = 0; m < 4; ++m) { g[ai][m] = __builtin_nontemporal_load((const u32x4*)(gbytes + (size_t)(row0 + ai * HALF + m * 16) * 64)); }
#pragma unroll
        for (int ai = 0; ai < 2; ++ai) {
            u32x4 pv[4][2];
            if (!first) {
#pragma unroll
                for (int m = 0; m < 4; ++m) load_pair<1024>(Y + (size_t)(row0 + ai * HALF + m * 16) * 1024 + ycol, fr, pv[m][0], pv[m][1]);
            } else {
#pragma unroll
                for (int m = 0; m < 4; ++m) { pv[m][0] = (u32x4){0u, 0u, 0u, 0u}; pv[m][1] = (u32x4){0u, 0u, 0u, 0u}; }
            }
#pragma unroll
            for (int m = 0; m < 4; ++m) { bf16_t* yp = Y + (size_t)(row0 + ai * HALF + m * 16) * 1024 + ycol;
                u32x4 wv[2];
#pragma unroll
                for (int bj = 0; bj < 2; ++bj) { const u32x2 gg = {g[ai][m][2 * bj], g[ai][m][2 * bj + 1]}; const u32x4 pp = pv[m][bj]; const f32x4 v0 = acc[ai][bj][m][0] * (1.f / 255.f), v1 = acc[ai][bj][m][1] * (1.f / 255.f);
#define GB(w_, k_) ((float)(((w_) >> (8 * (k_))) & 0xffu))
                    u32x4 w; w.x = pk2(bflo(pp.x) + v0[0] * GB(gg.x, 0), bfhi(pp.x) + v0[1] * GB(gg.x, 1)); w.y = pk2(bflo(pp.y) + v0[2] * GB(gg.x, 2), bfhi(pp.y) + v0[3] * GB(gg.x, 3));
                    w.z = pk2(bflo(pp.z) + v1[0] * GB(gg.y, 0), bfhi(pp.z) + v1[1] * GB(gg.y, 1)); w.w = pk2(bflo(pp.w) + v1[2] * GB(gg.y, 2), bfhi(pp.w) + v1[3] * GB(gg.y, 3));
#undef GB
                    wv[bj] = w; }
                store_pair<1024, false>(yp, fr, wv[0], wv[1]); }
        }
    }
};
struct EpiOut {
    float* outp; float* rowss;
    __device__ __forceinline__ void operator()(const f32x4 (&acc)[2][2][4][2], const Unit& u, int wr, int wc, int fr, int fq) const {
        asm volatile("" : "+v"(fr), "+v"(fq));
        const int row0 = u.pm * BM + wr * 64 + fr, col = u.pn * BM + wc * 64 + fq * 8;
#pragma unroll
        for (int ai = 0; ai < 2; ++ai)
#pragma unroll
            for (int m = 0; m < 4; ++m) { const int row = row0 + ai * HALF + m * 16; bf16_t* op = (bf16_t*)(outp + (size_t)row * 1024) + col; float ss = 0.f;
#pragma unroll
                for (int bj = 0; bj < 2; ++bj) { const f32x4 v0 = acc[ai][bj][m][0], v1 = acc[ai][bj][m][1];
                    const f32x4 q = v0 * v0 + v1 * v1; ss += (q[0] + q[1]) + (q[2] + q[3]); }
                store_pair<2048, true>(op, fr, pack8(acc[ai][0][m][0], acc[ai][0][m][1]), pack8(acc[ai][1][m][0], acc[ai][1][m][1]));
                ss += __shfl_xor(ss, 16); ss += __shfl_xor(ss, 32);
                if (fq == 0) atomicAdd(rowss + row, ss); }
    }
};
}

namespace attn_body {
using bf16=__hip_bfloat16;
using bf16x8=__attribute__((ext_vector_type(8)))short;
using s16x4=__attribute__((ext_vector_type(4)))short;
using f32x16=__attribute__((ext_vector_type(16)))float;
using u32x4=__attribute__((ext_vector_type(4)))unsigned;
constexpr int SEQ=4096,D=64,DM=256;
constexpr int CQ=4608,CK=5120,CV=5248,CG=6400,UP=512;
constexpr int NW=8,QBLK=32,QB=QBLK*NW,KVBLK=64;
__device__ __forceinline__ int crow(int r,int hi){return (r&3)+8*(r>>2)+4*hi;}
#define SBAR() __builtin_amdgcn_sched_barrier(0)
__device__ __forceinline__ void cmask(f32x16&p0,f32x16&p1,int jb,int qrel,int hi){
  const float NEG=-INFINITY; int kb=64*jb+4*hi;
  #pragma unroll
  for(int r=0;r<16;++r){int kv=kb+(r&3)+8*(r>>2); if(kv>qrel)p0[r]=NEG; if(kv+32>qrel)p1[r]=NEG;}
}

constexpr int NSLOT=3, SLOTB=8192;
constexpr int LDS_K=0, LDS_V=NSLOT*SLOTB, LDS_WS=2*NSLOT*SLOTB, LDS_OST=LDS_WS+NW*64*4, LDS_BYTES=LDS_OST+NW*4096;
constexpr float C2=0.125f*1.4426950408889634f;
__device__ __forceinline__ void glds16(const void*gsrc,unsigned lds_dst){unsigned keep;
  asm volatile("s_mov_b32 %0, m0\n\ts_mov_b32 m0, %2\n\ts_nop 0\n\tglobal_load_lds_dwordx4 %1, off\n\ts_mov_b32 m0, %0":"=&s"(keep):"v"(gsrc),"s"(lds_dst):"memory");}
__device__ __forceinline__ float max3f(float a,float b,float c){float r;asm("v_max3_f32 %0, %1, %2, %3":"=v"(r):"v"(a),"v"(b),"v"(c));return r;}
__device__ __forceinline__ float max2f(float a,float b){float r;asm("v_max_f32_e32 %0, %1, %2":"=v"(r):"v"(a),"v"(b));return r;}
__device__ __forceinline__ float fadd_s(float a,float b){float r;asm("v_add_f32_e32 %0, %1, %2":"=v"(r):"v"(a),"v"(b));return r;}
__device__ __forceinline__ float fsub_s(float a,float b){float r;asm("v_sub_f32_e32 %0, %1, %2":"=v"(r):"v"(a),"v"(b));return r;}
typedef float f32x2_t __attribute__((ext_vector_type(2))); typedef __bf16 bf16x2_t __attribute__((ext_vector_type(2)));
__device__ __forceinline__ unsigned cvtpk_s(float lo,float hi){f32x2_t v={lo,hi};bf16x2_t b=__builtin_convertvector(v,bf16x2_t);return __builtin_bit_cast(unsigned,b);}
#define WAIT_BAR(N) asm volatile("s_waitcnt vmcnt(" #N ") lgkmcnt(0)\n\ts_barrier":::"memory")

__device__ __forceinline__ void qkt(f32x16&p0,f32x16&p1,const char*Kslot,const bf16x8*qr,const f32x16&negm,int r32,int hi){
  const char*kb=Kslot+hi*1024+r32*16;
  #pragma unroll
  for(int d0=0;d0<4;++d0){
    const bf16x8 b0=*reinterpret_cast<const bf16x8*>(kb+d0*2048);
    const bf16x8 b1=*reinterpret_cast<const bf16x8*>(kb+d0*2048+512);
    if(d0==0){p0=__builtin_amdgcn_mfma_f32_32x32x16_bf16(b0,qr[0],negm,0,0,0);p1=__builtin_amdgcn_mfma_f32_32x32x16_bf16(b1,qr[0],negm,0,0,0);}
    else{p0=__builtin_amdgcn_mfma_f32_32x32x16_bf16(b0,qr[d0],p0,0,0,0);p1=__builtin_amdgcn_mfma_f32_32x32x16_bf16(b1,qr[d0],p1,0,0,0);}}
}
typedef __attribute__((address_space(3))) const char* lds_cptr;
typedef short v4i16_t __attribute__((ext_vector_type(4)));
__device__ __forceinline__ void kload8(bf16x8*kf,lds_cptr kp){
  kf[0]=*(const __attribute__((address_space(3))) bf16x8*)(kp);      kf[1]=*(const __attribute__((address_space(3))) bf16x8*)(kp+512);
  kf[2]=*(const __attribute__((address_space(3))) bf16x8*)(kp+2048); kf[3]=*(const __attribute__((address_space(3))) bf16x8*)(kp+2560);
  kf[4]=*(const __attribute__((address_space(3))) bf16x8*)(kp+4096); kf[5]=*(const __attribute__((address_space(3))) bf16x8*)(kp+4608);
  kf[6]=*(const __attribute__((address_space(3))) bf16x8*)(kp+6144); kf[7]=*(const __attribute__((address_space(3))) bf16x8*)(kp+6656);
}
__device__ __forceinline__ void kload2(bf16x8*kf,lds_cptr kp,int j){ kf[2*j]=*(const __attribute__((address_space(3))) bf16x8*)(kp+j*2048); kf[2*j+1]=*(const __attribute__((address_space(3))) bf16x8*)(kp+j*2048+512); }
__device__ __forceinline__ s16x4 vtr(lds_cptr p){ return __builtin_bit_cast(s16x4,__builtin_amdgcn_ds_read_tr16_b64_v4i16((__attribute__((address_space(3))) v4i16_t*)p)); }
__device__ __forceinline__ float rowmax(const f32x16&p0,const f32x16&p1){
  float a=max3f(p0[0],p0[1],p1[0]),b=max3f(p0[2],p0[3],p1[1]);a=max3f(a,p1[2],p1[3]);
  #pragma unroll
  for(int r=4;r<16;r+=4){a=max3f(a,p0[r],p0[r+1]);b=max3f(b,p0[r+2],p0[r+3]);a=max3f(a,p1[r],p1[r+1]);b=max3f(b,p1[r+2],p1[r+3]);}
  const float m=max2f(a,b);
  auto rr=__builtin_amdgcn_permlane32_swap(__float_as_uint(m),__float_as_uint(m),false,false);
  return max2f(__uint_as_float(rr[0]),__uint_as_float(rr[1]));
}
__device__ __forceinline__ void pv(f32x16*o,int vb,bf16x8 pa0,bf16x8 pa1,bf16x8 pa2,bf16x8 pa3){
  #pragma unroll
  for(int d0=0;d0<2;++d0){s16x4 lo[4],hi[4];
    #pragma unroll
    for(int ks=0;ks<4;++ks){
      asm volatile("ds_read_b64_tr_b16 %0,%1 offset:%c2":"=&v"(lo[ks]):"v"(vb),"i"(d0*4096+ks*1024):"memory");
      asm volatile("ds_read_b64_tr_b16 %0,%1 offset:%c2":"=&v"(hi[ks]):"v"(vb),"i"(d0*4096+ks*1024+512):"memory");}
    asm volatile("s_waitcnt lgkmcnt(0)":::"memory");SBAR();
    #define PK(k) (bf16x8){lo[k][0],lo[k][1],lo[k][2],lo[k][3],hi[k][0],hi[k][1],hi[k][2],hi[k][3]}
    o[d0]=__builtin_amdgcn_mfma_f32_32x32x16_bf16(pa0,PK(0),o[d0],0,0,0);
    o[d0]=__builtin_amdgcn_mfma_f32_32x32x16_bf16(pa1,PK(1),o[d0],0,0,0);
    o[d0]=__builtin_amdgcn_mfma_f32_32x32x16_bf16(pa2,PK(2),o[d0],0,0,0);
    o[d0]=__builtin_amdgcn_mfma_f32_32x32x16_bf16(pa3,PK(3),o[d0],0,0,0);
    #undef PK
  }
}

#ifndef ATTN_STORE16
#define ATTN_STORE16(p,v) (*(u32x4*)(p)=(v))
#endif
template<int THRL> __device__ __forceinline__ void attn_unit(long rowbase,int h,int qb,const bf16*__restrict__ Pm,bf16*Ub,char*shm){
  int tid_=threadIdx.x; asm volatile("":"+v"(tid_)); const int tid=tid_,lane=tid&63,r32=lane&31,hi=lane>>5; const int wid=__builtin_amdgcn_readfirstlane(tid>>6);
  const int q0=qb*QB;
  const bf16*Qw=Pm+pidx(rowbase+q0+wid*QBLK,CQ+h*D);
  const bf16*Kh=Pm+pidx(rowbase,CK+(h>>2)*D),*Vh=Pm+pidx(rowbase,CV+(h>>2)*D);
  const unsigned lds0=(unsigned)(uintptr_t)shm;
  float*wsf=(float*)(shm+LDS_WS)+wid*64;
  const bf16*ksrc=Kh+(long)lane*DM+wid*8;
  const bf16*vsrc=Vh+(long)(16*(wid&3)+(lane>>2))*DM+(wid>>2)*32+(lane&3)*8;
  const unsigned kdst=lds0+LDS_K+wid*1024, vdst=lds0+LDS_V+wid*1024;
  #define DMA_K(t,slot) glds16(ksrc+(long)(t)*KVBLK*DM,(unsigned)__builtin_amdgcn_readfirstlane(kdst+(slot)))
  #define DMA_V(t,slot) glds16(vsrc+(long)(t)*KVBLK*DM,(unsigned)__builtin_amdgcn_readfirstlane(vdst+(slot)))
  const int vb0=(int)(lds0+LDS_V)+((lane>>4)&1)*32+(lane&3)*8+(4*hi+((lane&15)>>2))*64;
  const char*Kbase=shm+LDS_K; bf16x8 kf[8];
  const lds_cptr shm3=(lds_cptr)shm; const lds_cptr kp0=shm3+LDS_K+hi*1024+r32*16; const lds_cptr vp0=shm3+LDS_V+((lane>>4)&1)*32+(lane&3)*8+(4*hi+((lane&15)>>2))*64;
  const int NT=SEQ/KVBLK;
  DMA_K(0,0);DMA_V(0,0);DMA_K(1,SLOTB);
  bf16x8 qr[4];
  #pragma unroll
  for(int d0=0;d0<4;++d0)qr[d0]=*reinterpret_cast<const bf16x8*>(&Qw[(long)r32*DM+d0*16+hi*8]);
  float mhat=0.f,l_reg=0.f;f32x16 o[2];o[0]=f32x16{};o[1]=f32x16{};f32x16 negm=f32x16{};asm volatile("":"+v"(negm));
  const int qrel=wid*QBLK+r32;
  #define CMASK(P0,P1,t) do{}while(0)
  bool resc=false;
  #define START(P0,P1) do{ const float rm=rowmax(P0,P1); resc=false; \
    { const float dl=rm; mhat=fadd_s(mhat,dl); \
      _Pragma("unroll") for(int r=0;r<16;++r){P0[r]=fsub_s(P0[r],dl);P1[r]=fsub_s(P1[r],dl);} \
      _Pragma("unroll") for(int r=0;r<16;++r)negm[r]=-mhat; asm volatile("":"+v"(negm)); } \
    _Pragma("unroll") for(int r=0;r<16;++r)P0[r]=__builtin_amdgcn_exp2f(P0[r]); }while(0)
  #define RESC() do{ if(resc){ asm volatile("s_waitcnt lgkmcnt(0)":::"memory"); \
      _Pragma("unroll") for(int d_=0;d_<2;++d_) _Pragma("unroll") for(int r=0;r<16;++r)o[d_][r]*=wsf[crow(r,hi)]; } }while(0)
  f32x16 pA0,pA1,pB0,pB1;
  int sl_prev=0,sl_cur=0,sl_next=SLOTB;
  #define ROT() do{sl_prev=sl_cur;sl_cur=sl_next;sl_next=(sl_next==(NSLOT-1)*SLOTB)?0:sl_next+SLOTB;}while(0)
  DMA_K(2,2*SLOTB);
  WAIT_BAR(3);
  qkt(pA0,pA1,Kbase,qr,negm,r32,hi);asm volatile("s_nop 15\n\ts_nop 7":"+v"(pA0),"+v"(pA1));CMASK(pA0,pA1,0);
  START(pA0,pA1);
  _Pragma("unroll") for(int r=0;r<16;++r)pA1[r]=__builtin_amdgcn_exp2f(pA1[r]);
  WAIT_BAR(0);
  DMA_K(3,0);DMA_V(1,SLOTB);
  ROT();
  kload8(kf,kp0+sl_cur);
  WAIT_BAR(2);
  s16x4 vlo[8],vhi[8]; u32x4 pw0,pw1,pw2,pw3;
  #define PKW(P,B) cvtpk_s(P[B],P[B+1])
  #define PAF(k) __builtin_bit_cast(bf16x8,pw##k)
  #define VFR(i) (bf16x8){vlo[i][0],vlo[i][1],vlo[i][2],vlo[i][3],vhi[i][0],vhi[i][1],vhi[i][2],vhi[i][3]}
  #define PIN(x) asm volatile("":"+v"(x))
  #define MX3(a,b,c) __builtin_fmaxf(__builtin_fmaxf((a),(b)),(c))
  #define GAPA(MF,A0,A1,A2,A3,W0,W1,PW) do{ MF; sacc+=A0; sacc+=A1; sacc+=A2; sacc+=A3; PIN(sacc); W0; W1; PIN(PW); SBAR(); }while(0)
  #define EX(v) __builtin_amdgcn_exp2f(v)
  #define GAPB(MF,X,B) do{ MF; X[B]=EX(X[B]); X[B+1]=EX(X[B+1]); X[B+2]=EX(X[B+2]); X[B+3]=EX(X[B+3]); PIN(X); SBAR(); }while(0)
  #define VRD(i) do{ vlo[i]=vtr(vp_+(((i)>>2)*4096+((i)&3)*1024)); vhi[i]=vtr(vp_+(((i)>>2)*4096+((i)&3)*1024+512)); }while(0)
  #define KRD(G,j) do{ if(G){ kload2(kf,kp0+sl_next,j); SBAR(); } }while(0)
  #define STEP(C0,C1,P0,P1,t,GK,GV,GL) do{ SBAR(); \
    const lds_cptr vp_=vp0+sl_prev; \
    VRD(0); SBAR(); float sacc=(P0[0]+P0[1]); \
    GAPA(C0=__builtin_amdgcn_mfma_f32_32x32x16_bf16(kf[0],qr[0],negm,0,0,0), P0[2],P0[3],P0[4],P0[5],     pw0[0]=PKW(P0,0), pw0[1]=PKW(P0,2), pw0); \
    VRD(4); SBAR(); GAPA(C1=__builtin_amdgcn_mfma_f32_32x32x16_bf16(kf[1],qr[0],negm,0,0,0), P0[6],P0[7],P0[8],P0[9],     pw0[2]=PKW(P0,4), pw0[3]=PKW(P0,6), pw0); \
    VRD(1); SBAR(); GAPA(C0=__builtin_amdgcn_mfma_f32_32x32x16_bf16(kf[2],qr[1],C0,0,0,0),   P0[10],P0[11],P0[12],P0[13], pw1[0]=PKW(P0,8), pw1[1]=PKW(P0,10), pw1); \
    VRD(5); SBAR(); GAPA(C1=__builtin_amdgcn_mfma_f32_32x32x16_bf16(kf[3],qr[1],C1,0,0,0),   P0[14],P0[15],P1[0],P1[1],   pw1[2]=PKW(P0,12),pw1[3]=PKW(P0,14), pw1); \
    VRD(2); SBAR(); GAPA(C0=__builtin_amdgcn_mfma_f32_32x32x16_bf16(kf[4],qr[2],C0,0,0,0),   P1[2],P1[3],P1[4],P1[5],     pw2[0]=PKW(P1,0), pw2[1]=PKW(P1,2), pw2); \
    VRD(6); SBAR(); GAPA(C1=__builtin_amdgcn_mfma_f32_32x32x16_bf16(kf[5],qr[2],C1,0,0,0),   P1[6],P1[7],P1[8],P1[9],     pw2[2]=PKW(P1,4), pw2[3]=PKW(P1,6), pw2); \
    VRD(3); SBAR(); GAPA(C0=__builtin_amdgcn_mfma_f32_32x32x16_bf16(kf[6],qr[3],C0,0,0,0),   P1[10],P1[11],P1[12],P1[13], pw3[0]=PKW(P1,8), pw3[1]=PKW(P1,10), pw3); \
    VRD(7); SBAR(); GAPA(C1=__builtin_amdgcn_mfma_f32_32x32x16_bf16(kf[7],qr[3],C1,0,0,0),   P1[14],P1[15],0.f,0.f,       pw3[2]=PKW(P1,12),pw3[3]=PKW(P1,14), pw3); \
    l_reg+=sacc; \
    if(GK){DMA_K((t)+3,sl_cur);} if(GV){DMA_V((t)+1,sl_next);} \
    CMASK(C0,C1,t); \
    { float a=MX3(C0[0],C0[1],C1[0]),b=MX3(C0[2],C0[3],C1[1]); a=MX3(a,C1[2],C1[3]); \
      _Pragma("unroll") for(int r=4;r<16;r+=4){a=MX3(a,C0[r],C0[r+1]);b=MX3(b,C0[r+2],C0[r+3]);a=MX3(a,C1[r],C1[r+1]);b=MX3(b,C1[r+2],C1[r+3]);} \
      float rm=__builtin_fmaxf(a,b); { auto rr=__builtin_amdgcn_permlane32_swap(__float_as_uint(rm),__float_as_uint(rm),false,false); rm=__builtin_fmaxf(__uint_as_float(rr[0]),__uint_as_float(rr[1])); } \
      resc=false; \
      if(__builtin_expect(__any(rm>(float)THRL),0)){ const float dl=__builtin_fmaxf(rm,0.f); mhat+=dl; \
        _Pragma("unroll") for(int r=0;r<16;++r){C0[r]-=dl;C1[r]-=dl;} \
        _Pragma("unroll") for(int r=0;r<16;++r)negm[r]=-mhat; asm volatile("":"+v"(negm)); \
        const float f=__builtin_amdgcn_exp2f(-dl); l_reg*=f; if(hi==0)wsf[r32]=f; resc=true; } } \
    SBAR(); \
    GAPB(o[0]=__builtin_amdgcn_mfma_f32_32x32x16_bf16(PAF(0),VFR(0),o[0],0,0,0), C0,0); \
    GAPB(o[1]=__builtin_amdgcn_mfma_f32_32x32x16_bf16(PAF(0),VFR(4),o[1],0,0,0), C0,4); \
    KRD(GL,0); GAPB(o[0]=__builtin_amdgcn_mfma_f32_32x32x16_bf16(PAF(1),VFR(1),o[0],0,0,0), C0,8); \
    KRD(GL,1); GAPB(o[1]=__builtin_amdgcn_mfma_f32_32x32x16_bf16(PAF(1),VFR(5),o[1],0,0,0), C0,12); \
    KRD(GL,2); GAPB(o[0]=__builtin_amdgcn_mfma_f32_32x32x16_bf16(PAF(2),VFR(2),o[0],0,0,0), C1,0); \
    KRD(GL,3); GAPB(o[1]=__builtin_amdgcn_mfma_f32_32x32x16_bf16(PAF(2),VFR(6),o[1],0,0,0), C1,4); \
    GAPB(o[0]=__builtin_amdgcn_mfma_f32_32x32x16_bf16(PAF(3),VFR(3),o[0],0,0,0), C1,8); \
    GAPB(o[1]=__builtin_amdgcn_mfma_f32_32x32x16_bf16(PAF(3),VFR(7),o[1],0,0,0), C1,12); \
    }while(0)
  int t=1;
  #undef CMASK
  #define CMASK(P0,P1,t) do{}while(0)
  for(;t+5<NT;t+=2){
    STEP(pB0,pB1,pA0,pA1,t,true,true,true);     WAIT_BAR(2); RESC(); ROT();
    STEP(pA0,pA1,pB0,pB1,t+1,true,true,true);   WAIT_BAR(2); RESC(); ROT();
  }
  #undef CMASK
  #define CMASK(P0,P1,t) do{}while(0)
  #define ENDW(tt) do{ if((tt)+3<NT){WAIT_BAR(2);} else if((tt)+2<NT){WAIT_BAR(1);} else {WAIT_BAR(0);} }while(0)
  for(;t+1<NT;t+=2){
    STEP(pB0,pB1,pA0,pA1,t,(t+3<NT),(t+1<NT),(t+1<NT));       ENDW(t);   RESC(); ROT();
    STEP(pA0,pA1,pB0,pB1,t+1,(t+4<NT),(t+2<NT),(t+2<NT));     ENDW(t+1); RESC(); ROT();
  }
  STEP(pB0,pB1,pA0,pA1,NT-1,false,false,false); RESC();
  { float sacc=pB0[0]+pB0[1]; _Pragma("unroll") for(int r=2;r<16;++r)sacc+=pB0[r]; _Pragma("unroll") for(int r=0;r<16;++r)sacc+=pB1[r]; l_reg+=sacc;
    pw0=(u32x4){PKW(pB0,0),PKW(pB0,2),PKW(pB0,4),PKW(pB0,6)};pw1=(u32x4){PKW(pB0,8),PKW(pB0,10),PKW(pB0,12),PKW(pB0,14)};pw2=(u32x4){PKW(pB1,0),PKW(pB1,2),PKW(pB1,4),PKW(pB1,6)};pw3=(u32x4){PKW(pB1,8),PKW(pB1,10),PKW(pB1,12),PKW(pB1,14)};
    SBAR(); pv(o,vb0+sl_cur,PAF(0),PAF(1),PAF(2),PAF(3)); }
  #undef PKW
  #undef PAF
  #undef VFR
  #undef PIN
  #undef MX3
  #undef GAPA
  #undef GAPB
  #undef EX
  #undef VRD
  #undef KRD
  #undef STEP
  #undef ENDW
  {auto rr=__builtin_amdgcn_permlane32_swap(__float_as_uint(l_reg),__float_as_uint(l_reg),false,false);l_reg=__uint_as_float(rr[0])+__uint_as_float(rr[1]);}
  if(hi==0)wsf[32+r32]=l_reg;asm volatile("s_waitcnt lgkmcnt(0)":::"memory");
  float rli[16];
  #pragma unroll
  for(int r=0;r<16;++r)rli[r]=__builtin_amdgcn_rcpf(wsf[32+crow(r,hi)]);
  bf16*Ow=Ub+(rowbase+q0+wid*QBLK)*UP+h*D; const bf16*Gw=Pm+pidx(rowbase+q0+wid*QBLK,CG+h*D);
  { bf16*stg=(bf16*)(shm+LDS_OST)+wid*2048;
    #pragma unroll
    for(int r=0;r<16;++r){const int orow=crow(r,hi);
      #pragma unroll
      for(int d0=0;d0<2;++d0)stg[orow*64+d0*32+r32]=__float2bfloat16(o[d0][r]*rli[r]);}
    asm volatile("s_waitcnt lgkmcnt(0)":::"memory");
    #pragma unroll
    for(int i=0;i<4;++i){const int row=i*8+(lane>>3),ch=lane&7; const u32x4 v=*(const u32x4*)(stg+row*64+ch*8); const u32x4 gt=*(const u32x4*)(Gw+(long)row*DM+ch*8); u32x4 w;
      _Pragma("unroll") for(int e=0;e<4;++e){const float lo=__uint_as_float(v[e]<<16)*__uint_as_float(gt[e]<<16),hh=__uint_as_float(v[e]&0xffff0000u)*__uint_as_float(gt[e]&0xffff0000u); w[e]=cvtpk_s(lo,hh);}
      ATTN_STORE16(Ow+(long)row*UP+ch*8,w);} }
  asm volatile("s_waitcnt lgkmcnt(0)\n\ts_barrier":::"memory");
  #undef DMA_K
  #undef DMA_V
  #undef CMASK
  #undef START
  #undef RESC
  #undef ROT
}
constexpr int ATTN_LDS_BYTES=LDS_BYTES;
#undef SBAR
#undef WAIT_BAR
}

namespace wa {
typedef short v4i16_t __attribute__((ext_vector_type(4)));
__device__ __forceinline__ int crow(int r, int hi) { return (r & 3) + 8 * (r >> 2) + 4 * hi; }
__device__ __forceinline__ s16x4 vtr(const LAS char* p) { return __builtin_bit_cast(s16x4, __builtin_amdgcn_ds_read_tr16_b64_v4i16((LAS v4i16_t*)p)); }

template <int DH> struct State { float m, l; f32x16 o[DH / 32]; };

template <int DH, bool MASK>
__device__ __forceinline__ void tile(State<DH>& st, const bf16x8 (&qf)[DH / 16], const LAS char* kl, const LAS char* vl, int lane, int dq) {
    constexpr int NS = DH / 16, ND = DH / 32, ROWB = DH * 2 + 16;
    const int r = lane & 31, h = lane >> 5;
    const LAS char* kp = kl + r * ROWB + 16 * h;
    f32x16 S = {};
#pragma unroll
    for (int s = 0; s < NS; ++s) S = __builtin_amdgcn_mfma_f32_32x32x16_bf16(*(const LAS bf16x8*)(kp + 32 * s), qf[s], S, 0, 0, 0);
    if (MASK) {
#pragma unroll
        for (int i = 0; i < 16; ++i) { const int d = dq - crow(i, h); if (d > 64 || d < -64) S[i] = -1e30f; }
    }
    float tmax = S[0];
#pragma unroll
    for (int i = 1; i < 16; ++i) tmax = fmaxf(tmax, S[i]);
    tmax = fmaxf(tmax, __shfl_xor(tmax, 32));
    const float mnew = fmaxf(st.m, tmax), alpha = __builtin_amdgcn_exp2f(st.m - mnew);
    st.m = mnew;
    float psum = 0.f;
#pragma unroll
    for (int i = 0; i < 16; ++i) { S[i] = __builtin_amdgcn_exp2f(S[i] - mnew); psum += S[i]; }
    st.l = st.l * alpha + psum;
#pragma unroll
    for (int d = 0; d < ND; ++d)
#pragma unroll
        for (int i = 0; i < 16; ++i) st.o[d][i] *= alpha;
    u32x4 p0, p1;
    p0.x = pk2(S[0], S[1]); p0.y = pk2(S[2], S[3]); p0.z = pk2(S[4], S[5]); p0.w = pk2(S[6], S[7]);
    p1.x = pk2(S[8], S[9]); p1.y = pk2(S[10], S[11]); p1.z = pk2(S[12], S[13]); p1.w = pk2(S[14], S[15]);
    const bf16x8 pf0 = __builtin_bit_cast(bf16x8, p0), pf1 = __builtin_bit_cast(bf16x8, p1);
    const int i16 = lane & 15, q4 = i16 >> 2, p4 = i16 & 3, blk = (lane >> 4) & 1;
    const LAS char* vb = vl + (4 * h + q4) * ROWB + 32 * blk + 8 * p4;
#pragma unroll
    for (int d = 0; d < ND; ++d) {
        const s16x4 lo0 = vtr(vb + d * 64), hi0 = vtr(vb + d * 64 + 8 * ROWB), lo1 = vtr(vb + d * 64 + 16 * ROWB), hi1 = vtr(vb + d * 64 + 24 * ROWB);
        const bf16x8 v0 = __builtin_shufflevector(lo0, hi0, 0, 1, 2, 3, 4, 5, 6, 7), v1 = __builtin_shufflevector(lo1, hi1, 0, 1, 2, 3, 4, 5, 6, 7);
        st.o[d] = __builtin_amdgcn_mfma_f32_32x32x16_bf16(v0, pf0, st.o[d], 0, 0, 0);
        st.o[d] = __builtin_amdgcn_mfma_f32_32x32x16_bf16(v1, pf1, st.o[d], 0, 0, 0);
    }
}

constexpr int A_ROWB = 144, A_KROWS = 384, A_VOFF = A_KROWS * A_ROWB, A_NU = BPC * 8 * 3 * 16;
struct AUnit { int b, hh, g, dil, res, sp; };
__device__ __forceinline__ AUnit a_decode(int uid) { AUnit u; const int rs = uid & 15; u.g = (uid >> 4) % 3; u.hh = (uid / 48) & 7; u.b = uid / 384; u.dil = (u.g == 0) ? 1 : (u.g == 1) ? 4 : 16; const int spr = 16 / u.dil; u.res = rs / spr; u.sp = rs % spr; return u; }
__device__ __forceinline__ void a_load(const bf16_t* __restrict__ P, int uid, int tid, int wave, int lane, u32x4 (&kr)[6], u32x4 (&vr)[6], bf16x8 (&qn)[4]) {
    const AUnit u = a_decode(uid); const int L = SEQ / u.dil, qcol = (u.g * 8 + u.hh) * 64;
    const size_t rb = (size_t)u.b * SEQ;
#pragma unroll
    for (int it = 0; it < 6; ++it) { const int idx = tid + 512 * it, row = idx >> 3, ch = idx & 7, m = 256 * u.sp - 64 + row;
        if (m >= 0 && m < L) { const size_t rw = rb + (size_t)(m * u.dil + u.res); kr[it] = *(const u32x4*)(P + pidx(rw, C_AK + qcol + ch * 8)); vr[it] = *(const u32x4*)(P + pidx(rw, C_AV + qcol + ch * 8)); } }
    { const int r = lane & 31, h = lane >> 5, mq = 256 * u.sp + 32 * wave + r; const bf16_t* qp = P + pidx(rb + (size_t)(mq * u.dil + u.res), C_AQ + qcol + 8 * h);
#pragma unroll
      for (int s = 0; s < 4; ++s) qn[s] = *(const bf16x8*)(qp + 16 * s); }
}
__device__ __forceinline__ void mixA_phase(const bf16_t* __restrict__ P, bf16_t* OA, float* LSE, LAS char* lds, int tid, int vcu, int G) {
    const int lane = tid & 63, wave = __builtin_amdgcn_readfirstlane(tid >> 6), r = lane & 31, h = lane >> 5;
    u32x4 kr[6], vr[6]; bf16x8 qn[4];
    int uid = vcu;
    if (uid < A_NU) a_load(P, uid, tid, wave, lane, kr, vr, qn);
    for (; uid < A_NU; uid += G) {
#pragma unroll
        for (int it = 0; it < 6; ++it) { const int idx = tid + 512 * it, row = idx >> 3, ch = idx & 7; *(LAS u32x4*)(lds + row * A_ROWB + ch * 16) = kr[it]; *(LAS u32x4*)(lds + A_VOFF + row * A_ROWB + ch * 16) = vr[it]; }
        bf16x8 qf[4];
#pragma unroll
        for (int s = 0; s < 4; ++s) qf[s] = qn[s];
        __syncthreads();
        if (uid + G < A_NU) a_load(P, uid + G, tid, wave, lane, kr, vr, qn);
        const AUnit u = a_decode(uid); const int L = SEQ / u.dil, m0 = 256 * u.sp + 32 * wave;
        State<64> st; st.o[0] = f32x16{}; st.o[1] = f32x16{};
        f32x16 S[5]; bool ok[5]; float mx = -1e30f;
        const LAS char* kp = lds + (32 * wave + r) * A_ROWB + 16 * h;
#pragma unroll
        for (int j = 0; j < 5; ++j) {
            const int mk0 = m0 - 64 + 32 * j; ok[j] = (mk0 >= 0 && mk0 < L);
            if (ok[j]) {
                f32x16 s_ = {};
#pragma unroll
                for (int s = 0; s < 4; ++s) s_ = __builtin_amdgcn_mfma_f32_32x32x16_bf16(*(const LAS bf16x8*)(kp + 32 * j * A_ROWB + 32 * s), qf[s], s_, 0, 0, 0);
                if (j == 0 || j == 4) {
                    const int dq = r + 64 - 32 * j;
#pragma unroll
                    for (int i = 0; i < 16; ++i) { const int d = dq - crow(i, h); if (d > 64 || d < -64) s_[i] = -1e30f; }
                }
#pragma unroll
                for (int i = 0; i < 16; ++i) mx = fmaxf(mx, s_[i]);
                S[j] = s_;
            }
        }
        mx = fmaxf(mx, __shfl_xor(mx, 32));
        float psum = 0.f;
        const int i16 = lane & 15, q4 = i16 >> 2, p4 = i16 & 3, blk = (lane >> 4) & 1;
        const LAS char* vb = lds + A_VOFF + (32 * wave + 4 * h + q4) * A_ROWB + 32 * blk + 8 * p4;
#pragma unroll
        for (int j = 0; j < 5; ++j) {
            if (ok[j]) {
                f32x16 s_ = S[j];
#pragma unroll
                for (int i = 0; i < 16; ++i) { s_[i] = __builtin_amdgcn_exp2f(s_[i] - mx); psum += s_[i]; }
                u32x4 p0, p1;
                p0.x = pk2(s_[0], s_[1]); p0.y = pk2(s_[2], s_[3]); p0.z = pk2(s_[4], s_[5]); p0.w = pk2(s_[6], s_[7]);
                p1.x = pk2(s_[8], s_[9]); p1.y = pk2(s_[10], s_[11]); p1.z = pk2(s_[12], s_[13]); p1.w = pk2(s_[14], s_[15]);
                const bf16x8 pf0 = __builtin_bit_cast(bf16x8, p0), pf1 = __builtin_bit_cast(bf16x8, p1);
                const LAS char* vj = vb + 32 * j * A_ROWB;
#pragma unroll
                for (int d = 0; d < 2; ++d) {
                    const s16x4 lo0 = vtr(vj + d * 64), hi0 = vtr(vj + d * 64 + 8 * A_ROWB), lo1 = vtr(vj + d * 64 + 16 * A_ROWB), hi1 = vtr(vj + d * 64 + 24 * A_ROWB);
                    const bf16x8 v0 = __builtin_shufflevector(lo0, hi0, 0, 1, 2, 3, 4, 5, 6, 7), v1 = __builtin_shufflevector(lo1, hi1, 0, 1, 2, 3, 4, 5, 6, 7);
                    st.o[d] = __builtin_amdgcn_mfma_f32_32x32x16_bf16(v0, pf0, st.o[d], 0, 0, 0);
                    st.o[d] = __builtin_amdgcn_mfma_f32_32x32x16_bf16(v1, pf1, st.o[d], 0, 0, 0);
                }
            }
        }
        st.m = mx; st.l = psum;
        const float lt = st.l + __shfl_xor(st.l, 32), inv = 1.f / lt;
        const size_t orow = (size_t)u.b * SEQ + (size_t)((m0 + r) * u.dil + u.res);
        LAS char* sg = lds + 2 * A_VOFF + wave * 4096;
#pragma unroll
        for (int d = 0; d < 2; ++d)
#pragma unroll
            for (int i4 = 0; i4 < 4; ++i4) { u32x2 w; w.x = pk2(st.o[d][4 * i4] * inv, st.o[d][4 * i4 + 1] * inv); w.y = pk2(st.o[d][4 * i4 + 2] * inv, st.o[d][4 * i4 + 3] * inv);
                *(LAS u32x2*)(sg + r * 128 + (((4 * d + i4) ^ (r & 7)) << 4) + 8 * h) = w; }
        if (h == 0) LSE[orow * 24 + u.g * 8 + u.hh] = st.m + __builtin_amdgcn_logf(lt);
        asm volatile("s_waitcnt lgkmcnt(0)" ::: "memory");
#pragma unroll
        for (int i = 0; i < 4; ++i) { const int row = i * 8 + (lane >> 3), ch = lane & 7;
            const u32x4 v = *(const LAS u32x4*)(sg + row * 128 + ((ch ^ (row & 7)) << 4));
            *(u32x4*)(OA + ((size_t)u.b * SEQ + (size_t)((m0 + row) * u.dil + u.res)) * 1536 + u.g * 512 + u.hh * 64 + ch * 8) = v; }
        __syncthreads();
    }
}

constexpr int M_ROWB = 272, M_VOFF = 256 * M_ROWB, M_NU = BPC * 4 * 8;
__device__ __forceinline__ void mixM_phase(const bf16_t* __restrict__ P, const bf16_t* __restrict__ KVM, bf16_t* UM, int bg0, LAS char* lds, int tid, int vcu, int G) {
    const int lane = tid & 63, wave = __builtin_amdgcn_readfirstlane(tid >> 6), r = lane & 31, h = lane >> 5;
    for (int uid = vcu; uid < M_NU; uid += G) {
        const int b = uid >> 5, hh = (uid >> 3) & 3, part = uid & 7;
        const bf16_t* Kb = KVM + (size_t)(bg0 + b) * NMEM * 1024 + hh * 128;
#pragma unroll
        for (int it = 0; it < 8; ++it) { const int idx = tid + 512 * it, row = idx >> 4, ch = idx & 15; const bf16_t* rp = Kb + (size_t)row * 1024 + ch * 8;
            const u32x4 kv = *(const u32x4*)rp, vv = *(const u32x4*)(rp + 512);
            *(LAS u32x4*)(lds + row * M_ROWB + ch * 16) = kv; *(LAS u32x4*)(lds + M_VOFF + row * M_ROWB + ch * 16) = vv; }
        __syncthreads();
        for (int t = 0; t < 2; ++t) {
            const long qrow = (long)b * SEQ + part * 512 + (wave * 2 + t) * 32 + r;
            bf16x8 qf[8];
            { const bf16_t* qp = P + pidx(qrow, C_MQ + hh * 128 + 8 * h);
#pragma unroll
              for (int s = 0; s < 8; ++s) qf[s] = *(const bf16x8*)(qp + 16 * s); }
            State<128> st; st.m = -1e30f; st.l = 0.f;
#pragma unroll
            for (int d = 0; d < 4; ++d) st.o[d] = f32x16{};
            for (int j = 0; j < 8; ++j) tile<128, false>(st, qf, lds + 32 * j * M_ROWB, lds + M_VOFF + 32 * j * M_ROWB, lane, 0);
            const float lt = st.l + __shfl_xor(st.l, 32), inv = 1.f / lt;
            const bf16_t* gp = P + pidx(qrow, C_GM + hh * 128 + 4 * h);
            bf16_t* op = UM + (size_t)qrow * 512 + hh * 128 + 4 * h;
#pragma unroll
            for (int d = 0; d < 4; ++d)
#pragma unroll
                for (int i4 = 0; i4 < 4; ++i4) { const u32x2 g = *(const u32x2*)(gp + 32 * d + 8 * i4); u32x2 w;
                    w.x = pk2(st.o[d][4 * i4] * inv * bflo(g.x), st.o[d][4 * i4 + 1] * inv * bfhi(g.x)); w.y = pk2(st.o[d][4 * i4 + 2] * inv * bflo(g.y), st.o[d][4 * i4 + 3] * inv * bfhi(g.y));
                    *(u32x2*)(op + 32 * d + 8 * i4) = w; }
        }
        __syncthreads();
    }
}
}

constexpr size_t MiB = 1u << 20;
constexpr size_t WS_ROWSS = 0;
constexpr size_t WS_BAR = 512 * 1024;
constexpr size_t WS_COSA = 1 * MiB, WS_SINA = WS_COSA + 512 * 1024;
constexpr size_t WS_COSB = 2 * MiB, WS_SINB = WS_COSB + 4096;
constexpr size_t WS_MEMN = 3 * MiB;
constexpr size_t WS_KVM = 11 * MiB;
constexpr size_t WS_WIN = 19 * MiB;
constexpr size_t WS_WMEM = 40 * MiB;
constexpr size_t WS_WBR = 42 * MiB;
constexpr size_t WS_WOUT = 45 * MiB;
constexpr size_t WS_U = 52 * MiB;
constexpr size_t WS_Y = WS_U + (size_t)3 * RC * 512 * 2;
constexpr size_t WS_H = WS_Y;
constexpr size_t WS_OA = WS_Y + (size_t)RC * 1024 * 2;
constexpr size_t WS_LSE = WS_OA + (size_t)RC * 1536 * 2;
constexpr size_t WS_P = WS_Y + (size_t)RC * 3072 * 2;
constexpr size_t WS_END = WS_P + (size_t)RC * PITCH * 2;
static_assert(WS_LSE + (size_t)RC * 24 * 4 <= WS_P, "mixer A scratch fits under Y");
static_assert(WS_WOUT + (size_t)1024 * 3072 * 2 <= WS_U && WS_WIN + (size_t)INW * 1024 * 2 <= WS_WMEM, "weight map");
static_assert(pg8::EP_P == WS_P && pg8::EP_KVM == WS_KVM && pg8::EP_COSA == WS_COSA && pg8::EP_SINA == WS_SINA && pg8::EP_COSB == WS_COSB && pg8::EP_SINB == WS_SINB, "epilogue offsets match the map");
static_assert(WS_END <= (size_t)1024 * MiB, "workspace map exceeds 4x the largest tensor");

constexpr int LDS_BYTES = 147456, MISC_OFF = 147440;
constexpr int NTHREADS = 512, NWAVES = 8;

typedef __attribute__((address_space(1))) unsigned char* gptr_t;
template <class T> __device__ __forceinline__ T* as_global(T* p) { return (T*)(__attribute__((address_space(1))) T*)p; }
struct Args { const float *p0, *p1, *p2, *p3, *p4, *p5, *p6, *p7, *p8, *p9, *p10, *p11, *p12, *p13; float* out; unsigned char* ws; double invA[32]; double invB[16]; int ph_lo, ph_hi; };
enum { I_X = 0, I_MEM, I_GPRE, I_WIN, I_BMERGE, I_QN, I_KN, I_GMEM, I_WMEMKV, I_WBRA, I_WBRB, I_WBRM, I_WOUT, I_GPOST };

__device__ __forceinline__ int sigma_inv(int n) {
    const int t = n & 255; return (n & ~255) + 128 * ((t >> 5) & 1) + 32 * ((t >> 6) & 3) + 16 * ((t >> 2) & 1) + 4 * ((t >> 3) & 3) + (t & 3);
}
__device__ __forceinline__ int sigma_inv_g(int n) {
    const int t = n & 255; return (n & ~255) + 128 * ((t >> 3) & 1) + 32 * ((t >> 6) & 3) + 16 * ((t >> 2) & 1) + 4 * ((t >> 4) & 3) + (t & 3);
}
__device__ __forceinline__ void transpose_item(const float* __restrict__ W, int N, bf16_t* WT, int ldo, int rowoff, int koff, LAS float* scr, int item, int lane, int gfrom = 0x7fffffff) {
    const int nblk = N / 32, kb = item / nblk, nb = item % nblk, k0 = 64 * kb, n0 = 32 * nb;
#pragma unroll 8
    for (int i = 0; i < 32; ++i) { const int kk = 2 * i + (lane >> 5); scr[kk * 33 + (lane & 31)] = W[(size_t)(k0 + kk) * N + n0 + (lane & 31)]; }
    asm volatile("s_waitcnt lgkmcnt(0)" ::: "memory");
    const int c = lane & 7;
#pragma unroll
    for (int j = 0; j < 4; ++j) { const int n = (lane >> 3) + 8 * j; const LAS float* s = scr + (8 * c) * 33 + n;
        u32x4 o; o.x = pk2(s[0 * 33], s[1 * 33]); o.y = pk2(s[2 * 33], s[3 * 33]); o.z = pk2(s[4 * 33], s[5 * 33]); o.w = pk2(s[6 * 33], s[7 * 33]);
        const int nn = n0 + n; *(u32x4*)(WT + (size_t)(rowoff + (nn >= gfrom ? sigma_inv_g(nn) : sigma_inv(nn))) * ldo + koff + k0 + 8 * c) = o; }
    asm volatile("s_waitcnt lgkmcnt(0)" ::: "memory");
}
__device__ __forceinline__ float wave_sum(float v) {
#pragma unroll
    for (int o = 1; o < 64; o <<= 1) v += __shfl_xor(v, o);
    return v;
}
__device__ __forceinline__ void rms_row_to_bf16(const float* __restrict__ xrow, const float* __restrict__ g, bf16_t* orow, int lane) {
    const f32x4* xr = (const f32x4*)xrow + lane; const f32x4* gr = (const f32x4*)g + lane;
    f32x4 v[4]; float s = 0.f;
#pragma unroll
    for (int j = 0; j < 4; ++j) { v[j] = xr[64 * j]; s += (v[j].x * v[j].x + v[j].y * v[j].y) + (v[j].z * v[j].z + v[j].w * v[j].w); }
    const float rstd = rsqrtf(wave_sum(s) * (1.f / 1024.f) + NORM_EPS);
    u32x2* o8 = (u32x2*)orow + lane;
#pragma unroll
    for (int j = 0; j < 4; ++j) { const f32x4 gg = gr[64 * j]; u32x2 w; w.x = pk2(v[j].x * rstd * gg.x, v[j].y * rstd * gg.y); w.y = pk2(v[j].z * rstd * gg.z, v[j].w * rstd * gg.w); o8[64 * j] = w; }
}
__device__ __forceinline__ void sincos_d(double ang, float& c, float& s) {
    const double n = rint(ang * 0.63661977236758134308);
    double y = fma(-n, 1.5707963267948966, ang); y = fma(-n, 6.123233995736766e-17, y);
    const int q = ((int)n) & 3; const double y2 = y * y;
    const double sy = y + y * y2 * (-1.0 / 6 + y2 * (1.0 / 120 + y2 * (-1.0 / 5040 + y2 * (1.0 / 362880 + y2 * (-1.0 / 39916800 + y2 * (1.0 / 6227020800.0))))));
    const double cy = 1.0 + y2 * (-0.5 + y2 * (1.0 / 24 + y2 * (-1.0 / 720 + y2 * (1.0 / 40320 + y2 * (-1.0 / 3628800 + y2 * (1.0 / 479001600.0))))));
    const double cc = (q == 0) ? cy : (q == 1) ? -sy : (q == 2) ? -cy : sy;
    const double ss = (q == 0) ? sy : (q == 1) ? cy : (q == 2) ? -sy : -cy;
    c = (float)cc; s = (float)ss;
}

typedef __attribute__((address_space(1))) unsigned gu32;
#define XB_TMO      128
#define XB_XCNT(j)  (256  + 64 * (j))
#define XB_XSUB(j)  (1280 + 64 * (j))
#define XB_XGEN(j)  (2304 + 64 * (j))
#define XB_TOP      3328
#define XB_TOPGEN   3392
#define XCD_BAR_WORDS 3456
#define XB_SPIN_CAP (1u << 18)

__device__ __forceinline__ unsigned xb_ld(unsigned* p)              { return __hip_atomic_load(p, __ATOMIC_RELAXED, __HIP_MEMORY_SCOPE_AGENT); }
__device__ __forceinline__ unsigned xb_add(unsigned* p, unsigned v) { return __hip_atomic_fetch_add(p, v, __ATOMIC_RELAXED, __HIP_MEMORY_SCOPE_AGENT); }
__device__ __forceinline__ unsigned xb_xcc_id() { return (unsigned)__builtin_amdgcn_s_getreg((3 << 11) | 20) & 0xFu; }
#define XB_SPIN(cond, bar) do { unsigned _sp = 0; while (cond) { __builtin_amdgcn_s_sleep(1); \
    if ((++_sp & 255u) == 0u) { if (xb_ld(&(bar)[XB_TMO])) break; if (_sp > XB_SPIN_CAP) { atomicAdd(&(bar)[XB_TMO], 1u); break; } } } } while (0)

struct XcdBarrier {
    unsigned* bar; unsigned x;
    volatile LAS unsigned* st;
};

__device__ __forceinline__ XcdBarrier xcd_barrier_post(unsigned* bar, volatile LAS unsigned* st) {
    XcdBarrier b; b.bar = bar; b.x = xb_xcc_id(); b.st = st;
    if (threadIdx.x == 0) (void)xb_add(&bar[XB_XCNT(b.x)], 1u);
    return b;
}
__device__ __forceinline__ void xcd_barrier_complete(unsigned* bar, unsigned x, unsigned& nloc, unsigned& nx) {
    const unsigned G = gridDim.x * gridDim.y * gridDim.z;
    unsigned sum, cnt, mine, sp = 0u;
    for (;;) {
        sum = 0u; cnt = 0u; mine = 0u;
#pragma unroll
        for (unsigned j = 0; j < 16; ++j) { const unsigned c = xb_ld(&bar[XB_XCNT(j)]); sum += c; cnt += (c > 0u) ? 1u : 0u; mine = (j == x) ? c : mine; }
        if (sum == G) break;
        __builtin_amdgcn_s_sleep(1);
        if ((++sp & 255u) == 0u) { if (xb_ld(&bar[XB_TMO])) break; if (sp > XB_SPIN_CAP) { atomicAdd(&bar[XB_TMO], 1u); break; } }
    }
    nloc = mine > 0u ? mine : 1u; nx = cnt > 0u ? cnt : 1u;
}

__device__ __forceinline__ void xcd_barrier(const XcdBarrier& b) {
    asm volatile("s_waitcnt vmcnt(0)" ::: "memory");
    __syncthreads();
    if (threadIdx.x == 0) {
        unsigned* bar = b.bar;
        __builtin_amdgcn_s_waitcnt(0);
        unsigned nloc = b.st[0], nx = b.st[1];
        if (nloc == 0u) { xcd_barrier_complete(bar, b.x, nloc, nx); b.st[0] = nloc; b.st[1] = nx; }
        const unsigned old = xb_add(&bar[XB_XSUB(b.x)], 1u);
        const unsigned gen = old / nloc;
        if (old + 1u == (gen + 1u) * nloc) {
            __builtin_amdgcn_fence(__ATOMIC_RELEASE, "agent");
            asm volatile("s_waitcnt vmcnt(0)" ::: "memory");
            const unsigned og = xb_add(&bar[XB_TOP], 1u);
            const unsigned tg = og / nx;
            if (og + 1u == (tg + 1u) * nx) xb_add(&bar[XB_TOPGEN], 1u);
            else XB_SPIN(xb_ld(&bar[XB_TOPGEN]) == tg, bar);
            __builtin_amdgcn_fence(__ATOMIC_ACQUIRE, "agent");
            xb_add(&bar[XB_XGEN(b.x)], 1u);
            asm volatile("s_waitcnt vmcnt(0)" ::: "memory");
        } else {
            XB_SPIN(xb_ld(&bar[XB_XGEN(b.x)]) == gen, bar);
            __builtin_amdgcn_fence(__ATOMIC_ACQUIRE, "agent");
            asm volatile("s_waitcnt vmcnt(0)" ::: "memory");
        }
    }
    __syncthreads();
}

__global__ void __launch_bounds__(NTHREADS, 2) mega_fwd(Args a) {
    extern __shared__ __attribute__((aligned(16))) unsigned char lds[];
    cg::grid_group grid = cg::this_grid();
    unsigned* const barw = (unsigned*)(a.ws + WS_BAR);
    { LAS unsigned* misc = (LAS unsigned*)((LAS unsigned char*)lds + MISC_OFF); if (threadIdx.x < 4) misc[threadIdx.x] = 0u;
      if (blockIdx.x == 0) for (int i = threadIdx.x; i < XCD_BAR_WORDS; i += NTHREADS) barw[i] = 0u;
      __syncthreads(); }
    XcdBarrier xb; xb.bar = barw; xb.x = 0; xb.st = nullptr;
#define IN(k) true
#define SEAM(k) do { gptr_t b_ = (gptr_t)a.ws; asm volatile("" : "+s"(b_)); xb.bar = (unsigned*)((unsigned char*)b_ + WS_BAR); xcd_barrier(xb); } while (0)
#define PHASE_VARS() \
    int tid = threadIdx.x; asm volatile("" : "+v"(tid)); gptr_t wsg_ = (gptr_t)a.ws; asm volatile("" : "+s"(wsg_)); unsigned char* ws = (unsigned char*)wsg_; const float* const in_[14] = {a.p0, a.p1, a.p2, a.p3, a.p4, a.p5, a.p6, a.p7, a.p8, a.p9, a.p10, a.p11, a.p12, a.p13}; (void)in_; \
    const int lane = tid & 63, wave = __builtin_amdgcn_readfirstlane(tid >> 6); \
    const int G = gridDim.x, bx = blockIdx.x, vcu = (G % 8 == 0) ? (bx % 8) * (G / 8) + bx / 8 : bx; \
    const int gw = vcu * NWAVES + wave, NGW = G * NWAVES; (void)gw; (void)NGW; (void)lane; (void)vcu; \
    LAS unsigned char* ldsl = (LAS unsigned char*)lds; (void)ldsl

    if (IN(0)) {
        PHASE_VARS();
        float* rowss = (float*)(ws + WS_ROWSS);
        float* cosA = (float*)(ws + WS_COSA); float* sinA = (float*)(ws + WS_SINA); float* cosB = (float*)(ws + WS_COSB); float* sinB = (float*)(ws + WS_SINB);
        bf16_t* MEMN = (bf16_t*)(ws + WS_MEMN); bf16_t* WIN = (bf16_t*)(ws + WS_WIN); bf16_t* WMEM = (bf16_t*)(ws + WS_WMEM); bf16_t* WBR = (bf16_t*)(ws + WS_WBR); bf16_t* WOUT = (bf16_t*)(ws + WS_WOUT);
        bf16_t* H = (bf16_t*)(ws + WS_H);
        LAS float* scr = (LAS float*)(ldsl + wave * 16384);
        constexpr int I_IN = (1024 / 64) * (INW / 32), I_MK = (1024 / 64) * (1024 / 32), I_BR = (512 / 64) * (1024 / 32), I_O = (1024 / 64) * (1024 / 32);
        constexpr int NITEMS = I_IN + I_MK + 3 * I_BR + I_O;
        for (int it = gw; it < NITEMS; it += NGW) {
            int r = it;
            if (r < I_IN) { transpose_item(in_[I_WIN], INW, WIN, 1024, 0, 0, scr, r, lane); continue; } r -= I_IN;
            if (r < I_MK) { transpose_item(in_[I_WMEMKV], 1024, WMEM, 1024, 0, 0, scr, r, lane); continue; } r -= I_MK;
            if (r < I_BR) { transpose_item(in_[I_WBRA], 1024, WBR, 512, 0, 0, scr, r, lane); continue; } r -= I_BR;
            if (r < I_BR) { transpose_item(in_[I_WBRB], 1024, WBR, 512, 1024, 0, scr, r, lane); continue; } r -= I_BR;
            if (r < I_BR) { transpose_item(in_[I_WBRM], 1024, WBR, 512, 2048, 0, scr, r, lane); continue; } r -= I_BR;
            transpose_item(in_[I_WOUT], 1024, WOUT, 1024, 0, 0, scr, r, lane);
        }
        for (int i = bx * NTHREADS + tid; i < SEQ * 32; i += G * NTHREADS) { float c, s; sincos_d((double)(i >> 5) * a.invA[i & 31], c, s); cosA[i] = c; sinA[i] = s; }
        for (int i = bx * NTHREADS + tid; i < 64 * 16; i += G * NTHREADS) { float c, s; sincos_d((double)(i >> 4) * a.invB[i & 15], c, s); cosB[i] = c; sinB[i] = s; }
        for (int i = bx * NTHREADS + tid; i < MTOT; i += G * NTHREADS) rowss[i] = 0.f;
        for (int m = gw; m < BATCH * NMEM; m += NGW) rms_row_to_bf16(in_[I_MEM] + (size_t)m * 1024, in_[I_GMEM], MEMN + (size_t)m * 1024, lane);
        for (int m = gw; m < RC; m += NGW) rms_row_to_bf16(in_[I_X] + (size_t)m * 1024, in_[I_GPRE], H + (size_t)m * 1024, lane);
    }
    grid.sync();
    xb = xcd_barrier_post(barw, (volatile LAS unsigned*)((LAS unsigned char*)lds + MISC_OFF));

    for (int c = 0; c < NCH; ++c) {
        const int pb = 1 + 6 * c;
        const size_t grow0 = (size_t)c * RC;

        if (IN(pb)) {
            PHASE_VARS();
            pg8::Sched S; S.nM = RC / 256; S.nN = INW / 256; S.nwg = S.nM * S.nN; S.nX = (c == 0) ? (BATCH * NMEM / 256) * 4 : 0; S.G = G; S.c = bx; S.seg3 = 0;
            S.A = (const char*)(ws + WS_H); S.B = (const char*)(ws + WS_WIN); S.A2 = (const char*)(ws + WS_MEMN); S.B2 = (const char*)(ws + WS_WMEM); S.tsA = (size_t)256 * 1024 * 2; S.tsB = (size_t)256 * 1024 * 2; S.grpStride = 0; S.grpShift = 31;
            pg8::EpiP1 E{ws, in_[I_BMERGE], in_[I_QN], in_[I_KN]};
            pg8::gemm_phase<pg8::EpiP1, pg8::Sched, true, true>(ldsl, 1024, S, E);
        }
        SEAM(pb);

        if (IN(pb + 1)) {
            PHASE_VARS();
            const bf16_t* P = (const bf16_t*)(ws + WS_P); bf16_t* U = (bf16_t*)(ws + WS_U); bf16_t* OA = (bf16_t*)(ws + WS_OA); float* LSE = (float*)(ws + WS_LSE);
            const int rcls = vcu & 3; int nb = 0, uid = vcu;
            for (; uid < BPC * 8 * 16 && nb < rcls; uid += G, ++nb) {
                const int pair = uid >> 6, sub = uid & 63, b = pair >> 1, h = (pair & 1) * 4 + (sub >> 4), qb = sub & 15;
                attn_body::attn_unit<8>((long)b * SEQ, h, qb, (const attn_body::bf16*)P, (attn_body::bf16*)(U + (size_t)RC * 512), (char*)lds);
            }
            __syncthreads();
            wa::mixA_phase(P, OA, LSE, (LAS char*)ldsl, tid, vcu, G);
            for (; uid < BPC * 8 * 16; uid += G) {
                const int pair = uid >> 6, sub = uid & 63, b = pair >> 1, h = (pair & 1) * 4 + (sub >> 4), qb = sub & 15;
                attn_body::attn_unit<8>((long)b * SEQ, h, qb, (const attn_body::bf16*)P, (attn_body::bf16*)(U + (size_t)RC * 512), (char*)lds);
            }
            __syncthreads();
        }
        if (IN(pb + 1)) {
            PHASE_VARS();
            const bf16_t* P = (const bf16_t*)(ws + WS_P); bf16_t* U = (bf16_t*)(ws + WS_U); const bf16_t* KVM = (const bf16_t*)(ws + WS_KVM);
            wa::mixM_phase(P, KVM, U + (size_t)2 * RC * 512, c * BPC, (LAS char*)ldsl, tid, vcu, G);
        }
        SEAM(pb + 1);
        if (IN(pb + 2)) {
            PHASE_VARS();
            const bf16_t* P = (const bf16_t*)(ws + WS_P); bf16_t* U = (bf16_t*)(ws + WS_U); const bf16_t* OA = (const bf16_t*)(ws + WS_OA); const float* LSE = (const float*)(ws + WS_LSE);
            for (int idx = bx * NTHREADS + tid; idx < RC * 64; idx += G * NTHREADS) {
                const int row = idx >> 6, c8 = idx & 63, hh = c8 >> 3;
                const float l0 = LSE[(size_t)row * 24 + hh], l1 = LSE[(size_t)row * 24 + 8 + hh], l2 = LSE[(size_t)row * 24 + 16 + hh];
                const float mx = fmaxf(l0, fmaxf(l1, l2));
                float w0 = __builtin_amdgcn_exp2f(l0 - mx), w1 = __builtin_amdgcn_exp2f(l1 - mx), w2 = __builtin_amdgcn_exp2f(l2 - mx);
                const float inv = 1.f / (w0 + w1 + w2); w0 *= inv; w1 *= inv; w2 *= inv;
                const bf16_t* op = OA + (size_t)row * 1536 + c8 * 8;
                const u32x4 o0 = *(const u32x4*)op, o1 = *(const u32x4*)(op + 512), o2 = *(const u32x4*)(op + 1024), gt = *(const u32x4*)(P + pidx(row, C_GA + c8 * 8));
                u32x4 w;
#pragma unroll
                for (int e = 0; e < 4; ++e) { const float vlo = (w0 * bflo(o0[e]) + w1 * bflo(o1[e]) + w2 * bflo(o2[e])) * bflo(gt[e]), vhi = (w0 * bfhi(o0[e]) + w1 * bfhi(o1[e]) + w2 * bfhi(o2[e])) * bfhi(gt[e]); w[e] = pk2(vlo, vhi); }
                *(u32x4*)(U + (size_t)row * 512 + c8 * 8) = w;
            }
        }
        SEAM(pb + 2);

        if (IN(pb + 3)) {
            PHASE_VARS();
            pg8::Sched S; S.nM = RC / 256; S.nN = 4; S.nwg = S.nM * S.nN; S.nX = 0; S.G = G; S.c = bx; S.seg3 = 1;
            S.A = (const char*)(ws + WS_U); S.B = (const char*)(ws + WS_WBR); S.A2 = S.A; S.B2 = S.B; S.tsA = (size_t)256 * 512 * 2; S.tsB = (size_t)256 * 512 * 2; S.grpStride = (size_t)RC * 512 * 2; S.grpShift = 2;
            pg8::EpiBr E{(const bf16_t*)(ws + WS_P), (bf16_t*)(ws + WS_Y)};
            pg8::gemm_phase<pg8::EpiBr, pg8::Sched, true, true>(ldsl, 512, S, E);
        }
        SEAM(pb + 3);

        if (IN(pb + 4)) {
            PHASE_VARS();
            pg8::Sched S; S.nM = RC / 256; S.nN = 4; S.nwg = S.nM * S.nN; S.nX = 0; S.G = G; S.c = bx; S.seg3 = 0;
            S.A = (const char*)(ws + WS_Y); S.B = (const char*)(ws + WS_WOUT); S.A2 = S.A; S.B2 = S.B; S.tsA = (size_t)256 * 1024 * 2; S.tsB = (size_t)256 * 1024 * 2; S.grpStride = 0; S.grpShift = 31;
            pg8::EpiOut E{a.out + grow0 * 1024, (float*)(ws + WS_ROWSS) + grow0};
            pg8::gemm_phase<pg8::EpiOut, pg8::Sched, true, true>(ldsl, 1024, S, E);
        }
        SEAM(pb + 4);

        if (IN(pb + 5)) {
            PHASE_VARS();
            const float* gpost = in_[I_GPOST]; const float* rowss = (const float*)(ws + WS_ROWSS); bf16_t* H = (bf16_t*)(ws + WS_H);
            for (int m = gw; m < RC; m += NGW) {
                const size_t row = grow0 + m; const float rstd = rsqrtf(rowss[row] * (1.f / 1024.f) + NORM_EPS);
                const f32x4* xr = (const f32x4*)(in_[I_X] + row * 1024) + lane; f32x4* orp = (f32x4*)(a.out + row * 1024) + lane; const f32x4* gr = (const f32x4*)gpost + lane;
                const u32x2* pr = (const u32x2*)(a.out + row * 1024) + lane;
                u32x2 pv[4];
#pragma unroll
                for (int j = 0; j < 4; ++j) pv[j] = __builtin_nontemporal_load(pr + 64 * j);
                asm volatile("s_waitcnt vmcnt(0)" ::: "memory");
#pragma unroll
                for (int j = 0; j < 4; ++j) { const f32x4 o = {bflo(pv[j].x), bfhi(pv[j].x), bflo(pv[j].y), bfhi(pv[j].y)}; __builtin_nontemporal_store(__builtin_nontemporal_load(xr + 64 * j) + o * rstd * gr[64 * j], orp + 64 * j); }
            }
            if (c + 1 < NCH) for (int m = gw; m < RC; m += NGW) rms_row_to_bf16(in_[I_X] + (grow0 + RC + m) * 1024, in_[I_GPRE], H + (size_t)m * 1024, lane);
        }
        if (c + 1 < NCH) SEAM(pb + 5);
    }
#undef IN
#undef SEAM
#undef PHASE_VARS
}

constexpr int N_PHASES = 1 + 6 * NCH;
extern "C" void kernel_launch(void* const* d_in, const int* in_sizes, int n_in, void* d_out, int out_size, void* d_ws, size_t ws_size, hipStream_t stream) {
    static int grid = 0;
    if (grid == 0) {
        if (n_in != 14 || in_sizes[0] != MTOT * 1024 || out_size != MTOT * 1024 || ws_size < WS_END) { fprintf(stderr, "kernel_launch: unexpected shapes (n_in %d, ws %zu, need %zu); nothing launched\n", n_in, ws_size, (size_t)WS_END); grid = -1; return; }
        int dev = 0, cus = 0, per_cu = 0;
        (void)hipGetDevice(&dev); (void)hipDeviceGetAttribute(&cus, hipDeviceAttributeMultiprocessorCount, dev);
        if (hipFuncSetAttribute((const void*)mega_fwd, hipFuncAttributeMaxDynamicSharedMemorySize, LDS_BYTES) != hipSuccess) { fprintf(stderr, "kernel_launch: hipFuncSetAttribute failed\n"); grid = -1; return; }
        if (hipOccupancyMaxActiveBlocksPerMultiprocessor(&per_cu, (const void*)mega_fwd, NTHREADS, LDS_BYTES) != hipSuccess || per_cu < 1) { fprintf(stderr, "kernel_launch: occupancy query reports %d\n", per_cu); per_cu = 1; }
        (void)hipGetLastError();
        grid = cus;
        if (grid > cus * per_cu) grid = cus * per_cu;
    }
    if (grid < 0) return;
    Args a{};
    { const float** pp = &a.p0; for (int i = 0; i < 14; ++i) pp[i] = (const float*)d_in[i]; }
    a.out = (float*)d_out; a.ws = (unsigned char*)d_ws;
    for (int i = 0; i < 32; ++i) a.invA[i] = pow(10000.0, -(double)i / 32.0);
    for (int i = 0; i < 16; ++i) a.invB[i] = pow(10000.0, -(double)i / 16.0);
    a.ph_lo = 0; a.ph_hi = N_PHASES;
    void* args[] = {&a};
    hipError_t e = hipLaunchCooperativeKernel((const void*)mega_fwd, dim3(grid), dim3(NTHREADS), args, LDS_BYTES, stream);
    if (e != hipSuccess) fprintf(stderr, "cooperative launch failed: %s (grid %d)\n", hipGetErrorString(e), grid);
}
```

```cpp
#include <hip/hip_runtime.h>
#include <hip/hip_cooperative_groups.h>
#include <hip/hip_bf16.h>
#include <cstdio>
#include <cstdint>
#include <cmath>
namespace cg = cooperative_groups;

#define LAS __attribute__((address_space(3)))
typedef unsigned short bf16_t;
typedef short bf16x8 __attribute__((ext_vector_type(8)));
typedef short s16x4 __attribute__((ext_vector_type(4)));
typedef float f32x2 __attribute__((ext_vector_type(2)));
typedef float f32x4 __attribute__((ext_vector_type(4)));
typedef float f32x16 __attribute__((ext_vector_type(16)));
typedef unsigned u32x2 __attribute__((ext_vector_type(2)));
typedef unsigned u32x4 __attribute__((ext_vector_type(4)));
typedef __bf16 bf16x2_t __attribute__((ext_vector_type(2)));

constexpr int BATCH = 16, SEQ = 4096, DM_ = 1024, MTOT = BATCH * SEQ;
constexpr int NCH = 2, BPC = BATCH / NCH, RC = BPC * SEQ;
constexpr int INW = 10496, PITCH = INW;
constexpr int C_AQ = 0, C_AK = 1536, C_AV = 3072, C_BQ = 4608, C_BK = 5120, C_BV = 5248, C_MQ = 5376, C_GA = 5888, C_GB = 6400, C_GM = 6912, C_MG = 7424;
constexpr int NMEM = 256;
constexpr size_t PTILE = (size_t)RC * 256;
__host__ __device__ __forceinline__ size_t pidx(size_t row, int col) { return (size_t)(col >> 8) * PTILE + row * 256 + (size_t)(col & 255); }
constexpr float LOG2E = 1.4426950408889634f;
constexpr float QS_A = 0.125f * LOG2E;
constexpr float QS_M = 0.08838834764831845f * LOG2E;
constexpr float NORM_EPS = 1e-6f;

__device__ __forceinline__ unsigned pk2(float lo, float hi) { f32x2 v = {lo, hi}; bf16x2_t b = __builtin_convertvector(v, bf16x2_t); return __builtin_bit_cast(unsigned, b); }
__device__ __forceinline__ float bflo(unsigned w) { return __uint_as_float(w << 16); }
__device__ __forceinline__ float bfhi(unsigned w) { return __uint_as_float(w & 0xffff0000u); }

namespace pg8 {
#define PG8_LAS __attribute__((address_space(3)))
constexpr int BM = 256, BK = 64, HALF = 128, HTB = HALF * BK * 2, STAGE_BYTES = 8 * HTB, NXCD = 8, WGM = 8;
__host__ __device__ __forceinline__ int lds_byte(int r, int c) { const int st = (r >> 4) * 2 + (c >> 5), rr = r & 15, cc = c & 31, ob = rr * 64 + cc * 2; return st * 1024 + (ob ^ (((ob >> 9) & 1) << 5)); }
__host__ __device__ __forceinline__ void stage_rc(int b, int& R, int& C) { const int st = b / 1024, sb = b % 1024, swz = sb ^ (((sb >> 9) & 1) << 5); R = (st >> 1) * 16 + swz / 64; C = (st & 1) * 32 + (swz % 64) / 2; }

struct Unit { int pm, pn, kind; };
struct Sched {
    int nM, nN, nwg, nX, G, c, seg3;
    const char *A, *B, *A2, *B2; size_t tsA, tsB, grpStride; int grpShift;
    __device__ __forceinline__ bool next(int i, Unit& u) const {
        const int seg = seg3 ? i % 3 : 0; if (seg3) i /= 3;
        int L = i * G + c; asm volatile("" : "+s"(L)); if (L >= nwg + nX) return false;
        if (L >= nwg) { const int e = L - nwg; u.pm = e >> 2; u.pn = e & 3; u.kind = 1; return true; }
        int wgid = L; { const int q = nwg / NXCD, r = nwg % NXCD, xcd = wgid % NXCD, off = wgid / NXCD; wgid = (xcd < r ? xcd * (q + 1) : r * (q + 1) + (xcd - r) * q) + off; }
        const int nig = WGM * nN, gid = wgid / nig, fm = gid * WGM, gsz = (nM - fm) < WGM ? (nM - fm) : WGM;
        u.pm = fm + ((wgid % nig) % gsz); u.pn = (wgid % nig) / gsz + 4 * seg; u.kind = 0; return true;
    }
    __device__ __forceinline__ const char* aptr(const Unit& u) const { return u.kind ? A2 + (size_t)u.pm * tsA : A + (size_t)(u.pn >> grpShift) * grpStride + (size_t)u.pm * tsA; }
    __device__ __forceinline__ const char* bptr(const Unit& u) const { return (u.kind ? B2 : B) + (size_t)u.pn * tsB; }
};
template <class Epi, class Sched, bool ALIGN_EPI = false, bool SP2 = false>
__device__ __forceinline__ void gemm_phase(PG8_LAS unsigned char* lds, const int K, const Sched& S, const Epi& E) {
    int tid_ = threadIdx.x; asm volatile("" : "+v"(tid_)); const int tid = tid_, wid = __builtin_amdgcn_readfirstlane(tid >> 6), lane = tid & 63, wr = wid >> 2, wc = wid & 3, fr = lane & 15, fq = lane >> 4;
    const int nt = K / BK;
    unsigned voffA[2], voffB[2];
#pragma unroll
    for (int i = 0; i < 2; ++i) { int R, C; stage_rc(tid * 16 + i * 8192, R, C); const int Rb = R;
        voffA[i] = (unsigned)(R * K + C) * 2u; voffB[i] = (unsigned)(Rb * K + C) * 2u; }
    const size_t kstep = (size_t)(BK * 2);
    const size_t hstep = (size_t)HALF * K * 2;
    const unsigned ldsw = (unsigned)wid * 1024u;
    const int aoff = lds_byte(wr * 64 + fr, fq * 8), boff = lds_byte(wc * 32 + fr, fq * 8);
#define PG8_SA(b, h) (((b) * 2 + (h)) * HTB)
#define PG8_SB(b, h) ((4 + (b) * 2 + (h)) * HTB)
#define PG8_STAGE(bufoff, gbase, voff) do { _Pragma("unroll") for (int _i = 0; _i < 2; ++_i) \
        __builtin_amdgcn_global_load_lds((const unsigned*)((const char*)(gbase) + (voff)[_i]), (PG8_LAS unsigned*)(lds + (bufoff) + ldsw + _i * 8192), 16, 0, 0); } while (0)
#define PG8_LDA(dst, b, h) do { _Pragma("unroll") for (int m = 0; m < 4; ++m) _Pragma("unroll") for (int k = 0; k < 2; ++k) dst[m][k] = *(const PG8_LAS bf16x8*)(lds + PG8_SA(b, h) + aoff + m * 2048 + k * 1024); } while (0)
#define PG8_LDB(dst, b, h) do { _Pragma("unroll") for (int n = 0; n < 2; ++n) _Pragma("unroll") for (int k = 0; k < 2; ++k) dst[n][k] = *(const PG8_LAS bf16x8*)(lds + PG8_SB(b, h) + boff + n * 2048 + k * 1024); } while (0)
#define PG8_MMA(ai, bj, At, Bt) do { __builtin_amdgcn_s_setprio(1); _Pragma("unroll") for (int m = 0; m < 4; ++m) _Pragma("unroll") for (int n = 0; n < 2; ++n) _Pragma("unroll") for (int k = 0; k < 2; ++k) \
        acc[ai][bj][m][n] = __builtin_amdgcn_mfma_f32_16x16x32_bf16(Bt[n][k], At[m][k], acc[ai][bj][m][n], 0, 0, 0); __builtin_amdgcn_s_setprio(0); } while (0)
#define PG8_WAIT_V(n) asm volatile("s_waitcnt vmcnt(" #n ")" ::: "memory")
#define PG8_WAIT_L(n) asm volatile("s_waitcnt lgkmcnt(" #n ")" ::: "memory")
#define PG8_BAR __builtin_amdgcn_s_barrier()
#define PG8_SCHED __builtin_amdgcn_sched_barrier(0)
    Unit cur, nxt; int ui = 0;
    if (!S.next(0, cur)) return;
    f32x4 acc[2][2][4][2];
#pragma unroll
    for (int a = 0; a < 2; ++a)
#pragma unroll
        for (int b = 0; b < 2; ++b)
#pragma unroll
            for (int m = 0; m < 4; ++m)
#pragma unroll
                for (int n = 0; n < 2; ++n) acc[a][b][m][n] = (f32x4){0.f, 0.f, 0.f, 0.f};
    bf16x8 At[4][2], B0[2][2], B1[2][2];
    const char* cA = S.aptr(cur); const char* cB = S.bptr(cur);
    if constexpr (SP2) {
        PG8_STAGE(PG8_SB(0, 0), cB, voffB); PG8_STAGE(PG8_SB(0, 1), cB + hstep, voffB); PG8_STAGE(PG8_SA(0, 0), cA, voffA); PG8_STAGE(PG8_SA(0, 1), cA + hstep, voffA);
        if (wr == 1) PG8_BAR;
        PG8_WAIT_V(2); PG8_BAR;
        PG8_STAGE(PG8_SB(1, 0), cB + kstep, voffB); PG8_STAGE(PG8_SA(1, 0), cA + kstep, voffA); PG8_STAGE(PG8_SB(1, 1), cB + hstep + kstep, voffB);
        PG8_WAIT_V(6); PG8_BAR;
    } else {
        PG8_STAGE(PG8_SB(0, 0), cB, voffB); PG8_STAGE(PG8_SA(0, 0), cA, voffA); PG8_STAGE(PG8_SB(0, 1), cB + hstep, voffB); PG8_STAGE(PG8_SA(0, 1), cA + hstep, voffA);
        if (wr == 1) PG8_BAR;
        PG8_WAIT_V(4); PG8_BAR;
        PG8_STAGE(PG8_SB(1, 0), cB + kstep, voffB); PG8_STAGE(PG8_SA(1, 0), cA + kstep, voffA); PG8_STAGE(PG8_SB(1, 1), cB + hstep + kstep, voffB);
        PG8_WAIT_V(6); PG8_BAR;
    }
    for (;;) {
        const bool has_next = S.next(ui + 1, nxt);
        const char* nA = has_next ? S.aptr(nxt) : cA; const char* nB = has_next ? S.bptr(nxt) : cB;
        for (int t = 0; t < nt; t += 2) {
            const bool last = (t == nt - 2);
            const char* a1 = cA + (size_t)(t + 1) * kstep;
            const char* a2 = last ? nA : cA + (size_t)(t + 2) * kstep; const char* b2 = last ? nB : cB + (size_t)(t + 2) * kstep;
            const char* a3 = a2 + kstep; const char* b3 = b2 + kstep;
            if constexpr (SP2) {
            PG8_LDB(B0, 0, 0); PG8_LDB(B1, 0, 1); PG8_SCHED; PG8_LDA(At, 0, 0); PG8_STAGE(PG8_SA(1, 1), a1 + hstep, voffA);
            PG8_WAIT_V(8); PG8_WAIT_L(0); PG8_BAR; PG8_MMA(0, 0, At, B0); PG8_MMA(0, 1, At, B1); PG8_BAR; PG8_SCHED;
            PG8_LDA(At, 0, 1); PG8_STAGE(PG8_SB(0, 0), b2, voffB); PG8_STAGE(PG8_SB(0, 1), b2 + hstep, voffB); PG8_STAGE(PG8_SA(0, 0), a2, voffA);
            PG8_WAIT_V(8); PG8_WAIT_L(0); PG8_BAR; PG8_MMA(1, 0, At, B0); PG8_MMA(1, 1, At, B1); PG8_BAR; PG8_SCHED;
            PG8_LDB(B0, 1, 0); PG8_LDB(B1, 1, 1); PG8_SCHED; PG8_LDA(At, 1, 0); PG8_STAGE(PG8_SA(0, 1), a2 + hstep, voffA);
            PG8_WAIT_V(8); PG8_WAIT_L(0); PG8_BAR; PG8_MMA(0, 0, At, B0); PG8_MMA(0, 1, At, B1); PG8_BAR; PG8_SCHED;
            PG8_LDA(At, 1, 1); PG8_STAGE(PG8_SB(1, 0), b3, voffB); PG8_STAGE(PG8_SB(1, 1), b3 + hstep, voffB); PG8_STAGE(PG8_SA(1, 0), a3, voffA);
            PG8_WAIT_V(8); PG8_WAIT_L(0); PG8_BAR; PG8_MMA(1, 0, At, B0); PG8_MMA(1, 1, At, B1); PG8_BAR; PG8_SCHED;
            } else {
            PG8_LDB(B0, 0, 0); PG8_SCHED; PG8_LDA(At, 0, 0); PG8_STAGE(PG8_SA(1, 1), a1 + hstep, voffA);
            PG8_WAIT_L(8); PG8_BAR; PG8_WAIT_L(0); PG8_MMA(0, 0, At, B0); PG8_BAR; PG8_SCHED;
            PG8_LDB(B1, 0, 1); PG8_STAGE(PG8_SB(0, 0), b2, voffB);
            PG8_BAR; PG8_WAIT_L(0); PG8_MMA(0, 1, At, B1); PG8_BAR;
            PG8_LDA(At, 0, 1); PG8_STAGE(PG8_SA(0, 0), a2, voffA);
            PG8_BAR; PG8_WAIT_L(0); PG8_MMA(1, 0, At, B0); PG8_BAR; PG8_SCHED;
            PG8_STAGE(PG8_SB(0, 1), b2 + hstep, voffB);
            PG8_WAIT_V(6); PG8_BAR; PG8_MMA(1, 1, At, B1); PG8_BAR;
            PG8_LDB(B0, 1, 0); PG8_SCHED; PG8_LDA(At, 1, 0); PG8_STAGE(PG8_SA(0, 1), a2 + hstep, voffA);
            PG8_WAIT_L(8); PG8_BAR; PG8_WAIT_L(0); PG8_MMA(0, 0, At, B0); PG8_BAR; PG8_SCHED;
            PG8_LDB(B1, 1, 1); PG8_STAGE(PG8_SB(1, 0), b3, voffB);
            PG8_BAR; PG8_WAIT_L(0); PG8_MMA(0, 1, At, B1); PG8_BAR;
            PG8_LDA(At, 1, 1); PG8_STAGE(PG8_SA(1, 0), a3, voffA);
            PG8_BAR; PG8_WAIT_L(0); PG8_MMA(1, 0, At, B0); PG8_BAR; PG8_SCHED;
            PG8_STAGE(PG8_SB(1, 1), b3 + hstep, voffB);
            PG8_WAIT_V(6); PG8_BAR; PG8_MMA(1, 1, At, B1); PG8_BAR;
            }
        }
        if constexpr (ALIGN_EPI) { if (wr == 0) PG8_BAR; }
        { E(acc, cur, wr, wc, fr, fq); }
        if (!has_next) break;
#pragma unroll
        for (int a = 0; a < 2; ++a)
#pragma unroll
            for (int b = 0; b < 2; ++b)
#pragma unroll
                for (int m = 0; m < 4; ++m)
#pragma unroll
                    for (int n = 0; n < 2; ++n) acc[a][b][m][n] = (f32x4){0.f, 0.f, 0.f, 0.f};
        cur = nxt; cA = nA; cB = nB; ++ui;
        if constexpr (ALIGN_EPI) { if (wr == 1) PG8_BAR; }
    }
    PG8_WAIT_V(0);
    if constexpr (!ALIGN_EPI) { if (wr == 0) PG8_BAR; }
    PG8_BAR;
#undef PG8_SA
#undef PG8_SB
#undef PG8_STAGE
#undef PG8_LDA
#undef PG8_LDB
#undef PG8_MMA
#undef PG8_WAIT_V
#undef PG8_WAIT_L
#undef PG8_BAR
#undef PG8_SCHED
}
__device__ __forceinline__ u32x4 pack8(const f32x4 a, const f32x4 b) { u32x4 w; w.x = pk2(a[0], a[1]); w.y = pk2(a[2], a[3]); w.z = pk2(b[0], b[1]); w.w = pk2(b[2], b[3]); return w; }
__device__ __forceinline__ u32x4 xor1(u32x4 v) {
    u32x4 r;
#pragma unroll
    for (int e = 0; e < 4; ++e) r[e] = (unsigned)__builtin_amdgcn_mov_dpp((int)v[e], 0xB1, 0xF, 0xF, true);
    return r;
}
template <int PITCH_ = 256, bool NT = true>
__device__ __forceinline__ void store_pair(bf16_t* rp, int fr, const u32x4 wA, const u32x4 wB) {
    const bool odd = fr & 1;
    const u32x4 t = odd ? wA : wB, r = xor1(t);
    const u32x4 s1 = odd ? r : wA, s2 = odd ? wB : r;
    bf16_t* p1 = rp + (odd ? -PITCH_ + 32 : 0); bf16_t* p2 = rp + (odd ? 32 : PITCH_);
    if (NT) { __builtin_nontemporal_store(s1, (u32x4*)p1); __builtin_nontemporal_store(s2, (u32x4*)p2); } else { *(u32x4*)p1 = s1; *(u32x4*)p2 = s2; }
}
__device__ __forceinline__ void store8(bf16_t* p, const f32x4 a, const f32x4 b) {
    u32x4 w; w.x = pk2(a[0], a[1]); w.y = pk2(a[2], a[3]); w.z = pk2(b[0], b[1]); w.w = pk2(b[2], b[3]); __builtin_nontemporal_store(w, (u32x4*)p);
}
constexpr size_t EP_COSA = (size_t)1 << 20, EP_SINA = EP_COSA + 512 * 1024, EP_COSB = (size_t)2 << 20, EP_SINB = EP_COSB + 4096, EP_KVM = (size_t)11 << 20;
constexpr size_t EP_P = ((size_t)52 << 20) + (size_t)3 * RC * 512 * 2 + (size_t)RC * 3072 * 2;
struct EpiP1 {
    unsigned char* ws; const float* bmerge; const float* qn; const float* kn;
    __device__ __forceinline__ void operator()(const f32x4 (&acc)[2][2][4][2], const Unit& u, int wr, int wc, int fr, int fq) const {
        asm volatile("" : "+v"(fr), "+v"(fq));
        float one = 1.f; asm volatile("" : "+v"(one));
        bf16_t* const P = (bf16_t*)(ws + EP_P); bf16_t* const KVM = (bf16_t*)(ws + EP_KVM);
        const float* const cosA = (const float*)(ws + EP_COSA); const float* const sinA = (const float*)(ws + EP_SINA); const float* const cosB = (const float*)(ws + EP_COSB); const float* const sinB = (const float*)(ws + EP_SINB);
        const int row0 = u.pm * BM + wr * 64 + fr;
        if (u.kind) {
            const int col = u.pn * BM + wc * 64 + fq * 8;
#pragma unroll
            for (int ai = 0; ai < 2; ++ai)
#pragma unroll
                for (int m = 0; m < 4; ++m) { bf16_t* rp = KVM + (size_t)(row0 + ai * HALF + m * 16) * 1024 + col;
#pragma unroll
                    for (int bj = 0; bj < 2; ++bj) store8(rp + bj * 32, acc[ai][bj][m][0], acc[ai][bj][m][1]); }
            return;
        }
        const int pn = u.pn, col = pn * BM + wc * 64 + fq * 8;
        int type;
        if (pn < 12) type = 0; else if (pn < 18) type = 1; else if (pn < 20) type = 2; else if (pn == 20) type = (wc < 2) ? 3 : 1;
        else if (pn < 23) type = 4; else if (pn < 29) type = 5; else type = 6;
        if (type == 0) {
            const float sc = ((pn < 6) ? QS_A : 1.f) * one;
#pragma unroll
            for (int ai = 0; ai < 2; ++ai) {
                f32x4 c0[4], c1[4], s0[4], s1[4];
#pragma unroll
                for (int m = 0; m < 4; ++m) { const int t = (row0 + ai * HALF + m * 16) & (SEQ - 1); const float* cp = cosA + t * 32 + fq * 8; const float* sp = sinA + t * 32 + fq * 8;
                    c0[m] = *(const f32x4*)cp; c1[m] = *(const f32x4*)(cp + 4); s0[m] = *(const f32x4*)sp; s1[m] = *(const f32x4*)(sp + 4); }
#pragma unroll
                for (int m = 0; m < 4; ++m) { const int row = row0 + ai * HALF + m * 16;
                    const f32x4 xa0 = acc[ai][0][m][0], xa1 = acc[ai][0][m][1], xb0 = acc[ai][1][m][0], xb1 = acc[ai][1][m][1];
                    const f32x4 ya0 = (xa0 * c0[m] - xb0 * s0[m]) * sc, ya1 = (xa1 * c1[m] - xb1 * s1[m]) * sc, yb0 = (xa0 * s0[m] + xb0 * c0[m]) * sc, yb1 = (xa1 * s1[m] + xb1 * c1[m]) * sc;
                    bf16_t* rp = P + pidx(row, col); store_pair(rp, fr, pack8(ya0, ya1), pack8(yb0, yb1)); }
            }
        } else if (type == 2 || type == 3) {
            const float* nw = (type == 2) ? qn : kn; const float sc = ((type == 2) ? QS_A : 1.f) * one; const float sg = (fq < 2) ? -1.f : 1.f; const int ib = (fq & 1) * 8;
            const f32x4 w00 = *(const f32x4*)(nw + fq * 8), w01 = *(const f32x4*)(nw + fq * 8 + 4), w10 = *(const f32x4*)(nw + 32 + fq * 8), w11 = *(const f32x4*)(nw + 32 + fq * 8 + 4);
#pragma unroll
            for (int ai = 0; ai < 2; ++ai)
#pragma unroll
                for (int m = 0; m < 4; ++m) { const int row = row0 + ai * HALF + m * 16, t = row & (SEQ - 1);
                    f32x4 xa0 = acc[ai][0][m][0], xa1 = acc[ai][0][m][1], xb0 = acc[ai][1][m][0], xb1 = acc[ai][1][m][1];
                    const f32x4 q2 = xa0 * xa0 + xa1 * xa1 + xb0 * xb0 + xb1 * xb1; float ss = (q2[0] + q2[1]) + (q2[2] + q2[3]);
                    ss += __shfl_xor(ss, 16); ss += __shfl_xor(ss, 32);
                    const float rstd = rsqrtf(ss * (one * (1.f / 64.f)) + NORM_EPS);
                    xa0 = xa0 * rstd * w00; xa1 = xa1 * rstd * w01; xb0 = xb0 * rstd * w10; xb1 = xb1 * rstd * w11;
                    const int pr = (t >> 6) * 16 + ib, pc = (t & 63) * 16 + ib;
                    const f32x4 cr0 = *(const f32x4*)(cosB + pr), cr1 = *(const f32x4*)(cosB + pr + 4), sr0 = *(const f32x4*)(sinB + pr), sr1 = *(const f32x4*)(sinB + pr + 4);
                    const f32x4 cc0 = *(const f32x4*)(cosB + pc), cc1 = *(const f32x4*)(cosB + pc + 4), sc0 = *(const f32x4*)(sinB + pc), sc1 = *(const f32x4*)(sinB + pc + 4);
                    f32x4 pa0, pa1, pb0, pb1;
#pragma unroll
                    for (int e = 0; e < 4; ++e) { pa0[e] = __shfl_xor(xa0[e], 32); pa1[e] = __shfl_xor(xa1[e], 32); pb0[e] = __shfl_xor(xb0[e], 32); pb1[e] = __shfl_xor(xb1[e], 32); }
                    const f32x4 ya0 = (xa0 * cr0 + pa0 * sr0 * sg) * sc, ya1 = (xa1 * cr1 + pa1 * sr1 * sg) * sc, yb0 = (xb0 * cc0 + pb0 * sc0 * sg) * sc, yb1 = (xb1 * cc1 + pb1 * sc1 * sg) * sc;
                    bf16_t* rp = P + pidx(row, col); store8(rp, ya0, ya1); store8(rp + 32, yb0, yb1); }
        } else if (type == 5) {
#pragma unroll
            for (int ai = 0; ai < 2; ++ai)
#pragma unroll
                for (int m = 0; m < 4; ++m) { bf16_t* rp = P + pidx(row0 + ai * HALF + m * 16, col);
                    u32x4 wv[2];
#pragma unroll
                    for (int bj = 0; bj < 2; ++bj) { f32x4 v0 = acc[ai][bj][m][0], v1 = acc[ai][bj][m][1];
#pragma unroll
                        for (int e = 0; e < 4; ++e) { v0[e] = v0[e] * __builtin_amdgcn_rcpf(1.f + __builtin_amdgcn_exp2f(-LOG2E * v0[e])); v1[e] = v1[e] * __builtin_amdgcn_rcpf(1.f + __builtin_amdgcn_exp2f(-LOG2E * v1[e])); }
                        wv[bj] = pack8(v0, v1); }
                    store_pair(rp, fr, wv[0], wv[1]); }
        } else if (type == 6) {
            const float* bp = bmerge + (pn * BM - C_MG) + wc * 64 + fq * 8;
            f32x4 b[2][2];
#pragma unroll
            for (int bj = 0; bj < 2; ++bj) { b[bj][0] = *(const f32x4*)(bp + 32 * bj); b[bj][1] = *(const f32x4*)(bp + 32 * bj + 4); }
            unsigned char* gbase = (unsigned char*)(P + (size_t)pn * PTILE) + (size_t)wc * ((size_t)RC * 64) + fq * 16;
#pragma unroll
            for (int ai = 0; ai < 2; ++ai)
#pragma unroll
                for (int m = 0; m < 4; ++m) { u32x4 w;
#pragma unroll
                    for (int bj = 0; bj < 2; ++bj)
#pragma unroll
                        for (int n = 0; n < 2; ++n) { const f32x4 v = acc[ai][bj][m][n] + b[bj][n]; unsigned r = 0u;
#pragma unroll
                            for (int e = 0; e < 4; ++e) { const float g = __builtin_amdgcn_rcpf(1.f + __builtin_amdgcn_exp2f(-LOG2E * v[e])); r = __builtin_amdgcn_cvt_pk_u8_f32(__builtin_rintf(g * 255.f), e, r); }
                            w[2 * bj + n] = r; }
                    __builtin_nontemporal_store(w, (u32x4*)(gbase + (size_t)(row0 + ai * HALF + m * 16) * 64)); }
        } else {
            const float sc = ((type == 4) ? QS_M : 1.f) * one;
#pragma unroll
            for (int ai = 0; ai < 2; ++ai)
#pragma unroll
                for (int m = 0; m < 4; ++m) { bf16_t* rp = P + pidx(row0 + ai * HALF + m * 16, col);
                    store_pair(rp, fr, pack8(acc[ai][0][m][0] * sc, acc[ai][0][m][1] * sc), pack8(acc[ai][1][m][0] * sc, acc[ai][1][m][1] * sc)); }
        }
    }
};
struct EpiBr {
    const bf16_t* __restrict__ P; bf16_t* Y;
    __device__ __forceinline__ void operator()(const f32x4 (&acc)[2][2][4][2], const Unit& u, int wr, int wc, int fr, int fq) const {
        asm volatile("" : "+v"(fr), "+v"(fq));
        const int row0 = u.pm * BM + wr * 64 + fr, colw = wc * 64 + fq * 8, ycol = (u.pn & 3) * BM + colw; const bool first = (u.pn < 4);
        const unsigned char* gbytes = (const unsigned char*)(P + (size_t)((C_MG >> 8) + u.pn) * PTILE) + (size_t)wc * ((size_t)RC * 64) + fq * 16;
        u32x4 g[2][4];
#pragma unroll
        for (int ai = 0; ai < 2; ++ai)
#pragma unroll
            for (int m = 0; m < 4; ++m) { g[ai][m] = __builtin_nontemporal_load((const u32x4*)(gbytes + (size_t)(row0 + ai * HALF + m * 16) * 64)); }
#pragma unroll
        for (int ai = 0; ai < 2; ++ai) {
            u32x4 pv[4][2];
            if (!first) {
#pragma unroll
                for (int m = 0; m < 4; ++m) { const bf16_t* yp = Y + (size_t)(row0 + ai * HALF + m * 16) * 1024 + ycol; pv[m][0] = *(const u32x4*)yp; pv[m][1] = *(const u32x4*)(yp + 32); }
            } else {
#pragma unroll
                for (int m = 0; m < 4; ++m) { pv[m][0] = (u32x4){0u, 0u, 0u, 0u}; pv[m][1] = (u32x4){0u, 0u, 0u, 0u}; }
            }
#pragma unroll
            for (int m = 0; m < 4; ++m) { bf16_t* yp = Y + (size_t)(row0 + ai * HALF + m * 16) * 1024 + ycol;
                u32x4 wv[2];
#pragma unroll
                for (int bj = 0; bj < 2; ++bj) { const u32x2 gg = {g[ai][m][2 * bj], g[ai][m][2 * bj + 1]}; const u32x4 pp = pv[m][bj]; const f32x4 v0 = acc[ai][bj][m][0] * (1.f / 255.f), v1 = acc[ai][bj][m][1] * (1.f / 255.f);
#define GB(w_, k_) ((float)(((w_) >> (8 * (k_))) & 0xffu))
                    u32x4 w; w.x = pk2(bflo(pp.x) + v0[0] * GB(gg.x, 0), bfhi(pp.x) + v0[1] * GB(gg.x, 1)); w.y = pk2(bflo(pp.y) + v0[2] * GB(gg.x, 2), bfhi(pp.y) + v0[3] * GB(gg.x, 3));
                    w.z = pk2(bflo(pp.z) + v1[0] * GB(gg.y, 0), bfhi(pp.z) + v1[1] * GB(gg.y, 1)); w.w = pk2(bflo(pp.w) + v1[2] * GB(gg.y, 2), bfhi(pp.w) + v1[3] * GB(gg.y, 3));
#undef GB
                    wv[bj] = w; }
                store_pair<1024, false>(yp, fr, wv[0], wv[1]); }
        }
    }
};
struct EpiOut {
    float* outp; float* rowss;
    __device__ __forceinline__ void operator()(const f32x4 (&acc)[2][2][4][2], const Unit& u, int wr, int wc, int fr, int fq) const {
        asm volatile("" : "+v"(fr), "+v"(fq));
        const int row0 = u.pm * BM + wr * 64 + fr, col = u.pn * BM + wc * 64 + fq * 8;
#pragma unroll
        for (int ai = 0; ai < 2; ++ai)
#pragma unroll
            for (int m = 0; m < 4; ++m) { const int row = row0 + ai * HALF + m * 16; bf16_t* op = (bf16_t*)(outp + (size_t)row * 1024) + col; float ss = 0.f;
#pragma unroll
                for (int bj = 0; bj < 2; ++bj) { const f32x4 v0 = acc[ai][bj][m][0], v1 = acc[ai][bj][m][1];
                    const f32x4 q = v0 * v0 + v1 * v1; ss += (q[0] + q[1]) + (q[2] + q[3]); }
                store_pair<2048, true>(op, fr, pack8(acc[ai][0][m][0], acc[ai][0][m][1]), pack8(acc[ai][1][m][0], acc[ai][1][m][1]));
                ss += __shfl_xor(ss, 16); ss += __shfl_xor(ss, 32);
                if (fq == 0) atomicAdd(rowss + row, ss); }
    }
};
}

namespace attn_body {
using bf16=__hip_bfloat16;
using bf16x8=__attribute__((ext_vector_type(8)))short;
using s16x4=__attribute__((ext_vector_type(4)))short;
using f32x16=__attribute__((ext_vector_type(16)))float;
using u32x4=__attribute__((ext_vector_type(4)))unsigned;
constexpr int SEQ=4096,D=64,DM=256;
constexpr int CQ=4608,CK=5120,CV=5248,CG=6400,UP=512;
constexpr int NW=8,QBLK=32,QB=QBLK*NW,KVBLK=64;
__device__ __forceinline__ int crow(int r,int hi){return (r&3)+8*(r>>2)+4*hi;}
#define SBAR() __builtin_amdgcn_sched_barrier(0)
__device__ __forceinline__ void cmask(f32x16&p0,f32x16&p1,int jb,int qrel,int hi){
  const float NEG=-INFINITY; int kb=64*jb+4*hi;
  #pragma unroll
  for(int r=0;r<16;++r){int kv=kb+(r&3)+8*(r>>2); if(kv>qrel)p0[r]=NEG; if(kv+32>qrel)p1[r]=NEG;}
}

constexpr int NSLOT=3, SLOTB=8192;
constexpr int LDS_K=0, LDS_V=NSLOT*SLOTB, LDS_WS=2*NSLOT*SLOTB, LDS_OST=LDS_WS+NW*64*4, LDS_BYTES=LDS_OST+NW*4096;
constexpr float C2=0.125f*1.4426950408889634f;
__device__ __forceinline__ void glds16(const void*gsrc,unsigned lds_dst){unsigned keep;
  asm volatile("s_mov_b32 %0, m0\n\ts_mov_b32 m0, %2\n\ts_nop 0\n\tglobal_load_lds_dwordx4 %1, off\n\ts_mov_b32 m0, %0":"=&s"(keep):"v"(gsrc),"s"(lds_dst):"memory");}
__device__ __forceinline__ float max3f(float a,float b,float c){float r;asm("v_max3_f32 %0, %1, %2, %3":"=v"(r):"v"(a),"v"(b),"v"(c));return r;}
__device__ __forceinline__ float max2f(float a,float b){float r;asm("v_max_f32_e32 %0, %1, %2":"=v"(r):"v"(a),"v"(b));return r;}
__device__ __forceinline__ float fadd_s(float a,float b){float r;asm("v_add_f32_e32 %0, %1, %2":"=v"(r):"v"(a),"v"(b));return r;}
__device__ __forceinline__ float fsub_s(float a,float b){float r;asm("v_sub_f32_e32 %0, %1, %2":"=v"(r):"v"(a),"v"(b));return r;}
typedef float f32x2_t __attribute__((ext_vector_type(2))); typedef __bf16 bf16x2_t __attribute__((ext_vector_type(2)));
__device__ __forceinline__ unsigned cvtpk_s(float lo,float hi){f32x2_t v={lo,hi};bf16x2_t b=__builtin_convertvector(v,bf16x2_t);return __builtin_bit_cast(unsigned,b);}
#define WAIT_BAR(N) asm volatile("s_waitcnt vmcnt(" #N ") lgkmcnt(0)\n\ts_barrier":::"memory")

__device__ __forceinline__ void qkt(f32x16&p0,f32x16&p1,const char*Kslot,const bf16x8*qr,const f32x16&negm,int r32,int hi){
  const char*kb=Kslot+hi*1024+r32*16;
  #pragma unroll
  for(int d0=0;d0<4;++d0){
    const bf16x8 b0=*reinterpret_cast<const bf16x8*>(kb+d0*2048);
    const bf16x8 b1=*reinterpret_cast<const bf16x8*>(kb+d0*2048+512);
    if(d0==0){p0=__builtin_amdgcn_mfma_f32_32x32x16_bf16(b0,qr[0],negm,0,0,0);p1=__builtin_amdgcn_mfma_f32_32x32x16_bf16(b1,qr[0],negm,0,0,0);}
    else{p0=__builtin_amdgcn_mfma_f32_32x32x16_bf16(b0,qr[d0],p0,0,0,0);p1=__builtin_amdgcn_mfma_f32_32x32x16_bf16(b1,qr[d0],p1,0,0,0);}}
}
typedef __attribute__((address_space(3))) const char* lds_cptr;
typedef short v4i16_t __attribute__((ext_vector_type(4)));
__device__ __forceinline__ void kload8(bf16x8*kf,lds_cptr kp){
  kf[0]=*(const __attribute__((address_space(3))) bf16x8*)(kp);      kf[1]=*(const __attribute__((address_space(3))) bf16x8*)(kp+512);
  kf[2]=*(const __attribute__((address_space(3))) bf16x8*)(kp+2048); kf[3]=*(const __attribute__((address_space(3))) bf16x8*)(kp+2560);
  kf[4]=*(const __attribute__((address_space(3))) bf16x8*)(kp+4096); kf[5]=*(const __attribute__((address_space(3))) bf16x8*)(kp+4608);
  kf[6]=*(const __attribute__((address_space(3))) bf16x8*)(kp+6144); kf[7]=*(const __attribute__((address_space(3))) bf16x8*)(kp+6656);
}
__device__ __forceinline__ void kload2(bf16x8*kf,lds_cptr kp,int j){ kf[2*j]=*(const __attribute__((address_space(3))) bf16x8*)(kp+j*2048); kf[2*j+1]=*(const __attribute__((address_space(3))) bf16x8*)(kp+j*2048+512); }
__device__ __forceinline__ s16x4 vtr(lds_cptr p){ return __builtin_bit_cast(s16x4,__builtin_amdgcn_ds_read_tr16_b64_v4i16((__attribute__((address_space(3))) v4i16_t*)p)); }
__device__ __forceinline__ float rowmax(const f32x16&p0,const f32x16&p1){
  float a=max3f(p0[0],p0[1],p1[0]),b=max3f(p0[2],p0[3],p1[1]);a=max3f(a,p1[2],p1[3]);
  #pragma unroll
  for(int r=4;r<16;r+=4){a=max3f(a,p0[r],p0[r+1]);b=max3f(b,p0[r+2],p0[r+3]);a=max3f(a,p1[r],p1[r+1]);b=max3f(b,p1[r+2],p1[r+3]);}
  const float m=max2f(a,b);
  auto rr=__builtin_amdgcn_permlane32_swap(__float_as_uint(m),__float_as_uint(m),false,false);
  return max2f(__uint_as_float(rr[0]),__uint_as_float(rr[1]));
}
__device__ __forceinline__ void pv(f32x16*o,int vb,bf16x8 pa0,bf16x8 pa1,bf16x8 pa2,bf16x8 pa3){
  #pragma unroll
  for(int d0=0;d0<2;++d0){s16x4 lo[4],hi[4];
    #pragma unroll
    for(int ks=0;ks<4;++ks){
      asm volatile("ds_read_b64_tr_b16 %0,%1 offset:%c2":"=&v"(lo[ks]):"v"(vb),"i"(d0*4096+ks*1024):"memory");
      asm volatile("ds_read_b64_tr_b16 %0,%1 offset:%c2":"=&v"(hi[ks]):"v"(vb),"i"(d0*4096+ks*1024+512):"memory");}
    asm volatile("s_waitcnt lgkmcnt(0)":::"memory");SBAR();
    #define PK(k) (bf16x8){lo[k][0],lo[k][1],lo[k][2],lo[k][3],hi[k][0],hi[k][1],hi[k][2],hi[k][3]}
    o[d0]=__builtin_amdgcn_mfma_f32_32x32x16_bf16(pa0,PK(0),o[d0],0,0,0);
    o[d0]=__builtin_amdgcn_mfma_f32_32x32x16_bf16(pa1,PK(1),o[d0],0,0,0);
    o[d0]=__builtin_amdgcn_mfma_f32_32x32x16_bf16(pa2,PK(2),o[d0],0,0,0);
    o[d0]=__builtin_amdgcn_mfma_f32_32x32x16_bf16(pa3,PK(3),o[d0],0,0,0);
    #undef PK
  }
}

#ifndef ATTN_STORE16
#define ATTN_STORE16(p,v) (*(u32x4*)(p)=(v))
#endif
template<int THRL> __device__ __forceinline__ void attn_unit(long rowbase,int h,int qb,const bf16*__restrict__ Pm,bf16*Ub,char*shm){
  int tid_=threadIdx.x; asm volatile("":"+v"(tid_)); const int tid=tid_,lane=tid&63,r32=lane&31,hi=lane>>5; const int wid=__builtin_amdgcn_readfirstlane(tid>>6);
  const int q0=qb*QB;
  const bf16*Qw=Pm+pidx(rowbase+q0+wid*QBLK,CQ+h*D);
  const bf16*Kh=Pm+pidx(rowbase,CK+(h>>2)*D),*Vh=Pm+pidx(rowbase,CV+(h>>2)*D);
  const unsigned lds0=(unsigned)(uintptr_t)shm;
  float*wsf=(float*)(shm+LDS_WS)+wid*64;
  const bf16*ksrc=Kh+(long)lane*DM+wid*8;
  const bf16*vsrc=Vh+(long)(16*(wid&3)+(lane>>2))*DM+(wid>>2)*32+(lane&3)*8;
  const unsigned kdst=lds0+LDS_K+wid*1024, vdst=lds0+LDS_V+wid*1024;
  #define DMA_K(t,slot) glds16(ksrc+(long)(t)*KVBLK*DM,(unsigned)__builtin_amdgcn_readfirstlane(kdst+(slot)))
  #define DMA_V(t,slot) glds16(vsrc+(long)(t)*KVBLK*DM,(unsigned)__builtin_amdgcn_readfirstlane(vdst+(slot)))
  const int vb0=(int)(lds0+LDS_V)+((lane>>4)&1)*32+(lane&3)*8+(4*hi+((lane&15)>>2))*64;
  const char*Kbase=shm+LDS_K; bf16x8 kf[8];
  const lds_cptr shm3=(lds_cptr)shm; const lds_cptr kp0=shm3+LDS_K+hi*1024+r32*16; const lds_cptr vp0=shm3+LDS_V+((lane>>4)&1)*32+(lane&3)*8+(4*hi+((lane&15)>>2))*64;
  const int NT=SEQ/KVBLK;
  DMA_K(0,0);DMA_V(0,0);DMA_K(1,SLOTB);
  bf16x8 qr[4];
  #pragma unroll
  for(int d0=0;d0<4;++d0)qr[d0]=*reinterpret_cast<const bf16x8*>(&Qw[(long)r32*DM+d0*16+hi*8]);
  float mhat=0.f,l_reg=0.f;f32x16 o[2];o[0]=f32x16{};o[1]=f32x16{};f32x16 negm=f32x16{};asm volatile("":"+v"(negm));
  const int qrel=wid*QBLK+r32;
  #define CMASK(P0,P1,t) do{}while(0)
  bool resc=false;
  #define START(P0,P1) do{ const float rm=rowmax(P0,P1); resc=false; \
    { const float dl=rm; mhat=fadd_s(mhat,dl); \
      _Pragma("unroll") for(int r=0;r<16;++r){P0[r]=fsub_s(P0[r],dl);P1[r]=fsub_s(P1[r],dl);} \
      _Pragma("unroll") for(int r=0;r<16;++r)negm[r]=-mhat; asm volatile("":"+v"(negm)); } \
    _Pragma("unroll") for(int r=0;r<16;++r)P0[r]=__builtin_amdgcn_exp2f(P0[r]); }while(0)
  #define RESC() do{ if(resc){ asm volatile("s_waitcnt lgkmcnt(0)":::"memory"); \
      _Pragma("unroll") for(int d_=0;d_<2;++d_) _Pragma("unroll") for(int r=0;r<16;++r)o[d_][r]*=wsf[crow(r,hi)]; } }while(0)
  f32x16 pA0,pA1,pB0,pB1;
  int sl_prev=0,sl_cur=0,sl_next=SLOTB;
  #define ROT() do{sl_prev=sl_cur;sl_cur=sl_next;sl_next=(sl_next==(NSLOT-1)*SLOTB)?0:sl_next+SLOTB;}while(0)
  DMA_K(2,2*SLOTB);
  WAIT_BAR(3);
  qkt(pA0,pA1,Kbase,qr,negm,r32,hi);asm volatile("s_nop 15\n\ts_nop 7":"+v"(pA0),"+v"(pA1));CMASK(pA0,pA1,0);
  START(pA0,pA1);
  _Pragma("unroll") for(int r=0;r<16;++r)pA1[r]=__builtin_amdgcn_exp2f(pA1[r]);
  WAIT_BAR(0);
  DMA_K(3,0);DMA_V(1,SLOTB);
  ROT();
  kload8(kf,kp0+sl_cur);
  WAIT_BAR(2);
  s16x4 vlo[8],vhi[8]; u32x4 pw0,pw1,pw2,pw3;
  #define PKW(P,B) cvtpk_s(P[B],P[B+1])
  #define PAF(k) __builtin_bit_cast(bf16x8,pw##k)
  #define VFR(i) (bf16x8){vlo[i][0],vlo[i][1],vlo[i][2],vlo[i][3],vhi[i][0],vhi[i][1],vhi[i][2],vhi[i][3]}
  #define PIN(x) asm volatile("":"+v"(x))
  #define MX3(a,b,c) __builtin_fmaxf(__builtin_fmaxf((a),(b)),(c))
  #define GAPA(MF,A0,A1,A2,A3,W0,W1,PW) do{ MF; sacc+=A0; sacc+=A1; sacc+=A2; sacc+=A3; PIN(sacc); W0; W1; PIN(PW); SBAR(); }while(0)
  #define EX(v) __builtin_amdgcn_exp2f(v)
  #define GAPB(MF,X,B) do{ MF; X[B]=EX(X[B]); X[B+1]=EX(X[B+1]); X[B+2]=EX(X[B+2]); X[B+3]=EX(X[B+3]); PIN(X); SBAR(); }while(0)
  #define VRD(i) do{ vlo[i]=vtr(vp_+(((i)>>2)*4096+((i)&3)*1024)); vhi[i]=vtr(vp_+(((i)>>2)*4096+((i)&3)*1024+512)); }while(0)
  #define KRD(G,j) do{ if(G){ kload2(kf,kp0+sl_next,j); SBAR(); } }while(0)
  #define STEP(C0,C1,P0,P1,t,GK,GV,GL) do{ SBAR(); \
    const lds_cptr vp_=vp0+sl_prev; \
    VRD(0); SBAR(); float sacc=(P0[0]+P0[1]); \
    GAPA(C0=__builtin_amdgcn_mfma_f32_32x32x16_bf16(kf[0],qr[0],negm,0,0,0), P0[2],P0[3],P0[4],P0[5],     pw0[0]=PKW(P0,0), pw0[1]=PKW(P0,2), pw0); \
    VRD(4); SBAR(); GAPA(C1=__builtin_amdgcn_mfma_f32_32x32x16_bf16(kf[1],qr[0],negm,0,0,0), P0[6],P0[7],P0[8],P0[9],     pw0[2]=PKW(P0,4), pw0[3]=PKW(P0,6), pw0); \
    VRD(1); SBAR(); GAPA(C0=__builtin_amdgcn_mfma_f32_32x32x16_bf16(kf[2],qr[1],C0,0,0,0),   P0[10],P0[11],P0[12],P0[13], pw1[0]=PKW(P0,8), pw1[1]=PKW(P0,10), pw1); \
    VRD(5); SBAR(); GAPA(C1=__builtin_amdgcn_mfma_f32_32x32x16_bf16(kf[3],qr[1],C1,0,0,0),   P0[14],P0[15],P1[0],P1[1],   pw1[2]=PKW(P0,12),pw1[3]=PKW(P0,14), pw1); \
    VRD(2); SBAR(); GAPA(C0=__builtin_amdgcn_mfma_f32_32x32x16_bf16(kf[4],qr[2],C0,0,0,0),   P1[2],P1[3],P1[4],P1[5],     pw2[0]=PKW(P1,0), pw2[1]=PKW(P1,2), pw2); \
    VRD(6); SBAR(); GAPA(C1=__builtin_amdgcn_mfma_f32_32x32x16_bf16(kf[5],qr[2],C1,0,0,0),   P1[6],P1[7],P1[8],P1[9],     pw2[2]=PKW(P1,4), pw2[3]=PKW(P1,6), pw2); \
    VRD(3); SBAR(); GAPA(C0=__builtin_amdgcn_mfma_f32_32x32x16_bf16(kf[6],qr[3],C0,0,0,0),   P1[10],P1[11],P1[12],P1[13], pw3[0]=PKW(P1,8), pw3[1]=PKW(P1,10), pw3); \
    VRD(7); SBAR(); GAPA(C1=__builtin_amdgcn_mfma_f32_32x32x16_bf16(kf[7],qr[3],C1,0,0,0),   P1[14],P1[15],0.f,0.f,       pw3[2]=PKW(P1,12),pw3[3]=PKW(P1,14), pw3); \
    l_reg+=sacc; \
    if(GK){DMA_K((t)+3,sl_cur);} if(GV){DMA_V((t)+1,sl_next);} \
    CMASK(C0,C1,t); \
    { float a=MX3(C0[0],C0[1],C1[0]),b=MX3(C0[2],C0[3],C1[1]); a=MX3(a,C1[2],C1[3]); \
      _Pragma("unroll") for(int r=4;r<16;r+=4){a=MX3(a,C0[r],C0[r+1]);b=MX3(b,C0[r+2],C0[r+3]);a=MX3(a,C1[r],C1[r+1]);b=MX3(b,C1[r+2],C1[r+3]);} \
      float rm=__builtin_fmaxf(a,b); { auto rr=__builtin_amdgcn_permlane32_swap(__float_as_uint(rm),__float_as_uint(rm),false,false); rm=__builtin_fmaxf(__uint_as_float(rr[0]),__uint_as_float(rr[1])); } \
      resc=false; \
      if(__builtin_expect(__any(rm>(float)THRL),0)){ const float dl=__builtin_fmaxf(rm,0.f); mhat+=dl; \
        _Pragma("unroll") for(int r=0;r<16;++r){C0[r]-=dl;C1[r]-=dl;} \
        _Pragma("unroll") for(int r=0;r<16;++r)negm[r]=-mhat; asm volatile("":"+v"(negm)); \
        const float f=__builtin_amdgcn_exp2f(-dl); l_reg*=f; if(hi==0)wsf[r32]=f; resc=true; } } \
    SBAR(); \
    GAPB(o[0]=__builtin_amdgcn_mfma_f32_32x32x16_bf16(PAF(0),VFR(0),o[0],0,0,0), C0,0); \
    GAPB(o[1]=__builtin_amdgcn_mfma_f32_32x32x16_bf16(PAF(0),VFR(4),o[1],0,0,0), C0,4); \
    KRD(GL,0); GAPB(o[0]=__builtin_amdgcn_mfma_f32_32x32x16_bf16(PAF(1),VFR(1),o[0],0,0,0), C0,8); \
    KRD(GL,1); GAPB(o[1]=__builtin_amdgcn_mfma_f32_32x32x16_bf16(PAF(1),VFR(5),o[1],0,0,0), C0,12); \
    KRD(GL,2); GAPB(o[0]=__builtin_amdgcn_mfma_f32_32x32x16_bf16(PAF(2),VFR(2),o[0],0,0,0), C1,0); \
    KRD(GL,3); GAPB(o[1]=__builtin_amdgcn_mfma_f32_32x32x16_bf16(PAF(2),VFR(6),o[1],0,0,0), C1,4); \
    GAPB(o[0]=__builtin_amdgcn_mfma_f32_32x32x16_bf16(PAF(3),VFR(3),o[0],0,0,0), C1,8); \
    GAPB(o[1]=__builtin_amdgcn_mfma_f32_32x32x16_bf16(PAF(3),VFR(7),o[1],0,0,0), C1,12); \
    }while(0)
  int t=1;
  #undef CMASK
  #define CMASK(P0,P1,t) do{}while(0)
  for(;t+5<NT;t+=2){
    STEP(pB0,pB1,pA0,pA1,t,true,true,true);     WAIT_BAR(2); RESC(); ROT();
    STEP(pA0,pA1,pB0,pB1,t+1,true,true,true);   WAIT_BAR(2); RESC(); ROT();
  }
  #undef CMASK
  #define CMASK(P0,P1,t) do{}while(0)
  #define ENDW(tt) do{ if((tt)+3<NT){WAIT_BAR(2);} else if((tt)+2<NT){WAIT_BAR(1);} else {WAIT_BAR(0);} }while(0)
  for(;t+1<NT;t+=2){
    STEP(pB0,pB1,pA0,pA1,t,(t+3<NT),(t+1<NT),(t+1<NT));       ENDW(t);   RESC(); ROT();
    STEP(pA0,pA1,pB0,pB1,t+1,(t+4<NT),(t+2<NT),(t+2<NT));     ENDW(t+1); RESC(); ROT();
  }
  STEP(pB0,pB1,pA0,pA1,NT-1,false,false,false); RESC();
  { float sacc=pB0[0]+pB0[1]; _Pragma("unroll") for(int r=2;r<16;++r)sacc+=pB0[r]; _Pragma("unroll") for(int r=0;r<16;++r)sacc+=pB1[r]; l_reg+=sacc;
    pw0=(u32x4){PKW(pB0,0),PKW(pB0,2),PKW(pB0,4),PKW(pB0,6)};pw1=(u32x4){PKW(pB0,8),PKW(pB0,10),PKW(pB0,12),PKW(pB0,14)};pw2=(u32x4){PKW(pB1,0),PKW(pB1,2),PKW(pB1,4),PKW(pB1,6)};pw3=(u32x4){PKW(pB1,8),PKW(pB1,10),PKW(pB1,12),PKW(pB1,14)};
    SBAR(); pv(o,vb0+sl_cur,PAF(0),PAF(1),PAF(2),PAF(3)); }
  #undef PKW
  #undef PAF
  #undef VFR
  #undef PIN
  #undef MX3
  #undef GAPA
  #undef GAPB
  #undef EX
  #undef VRD
  #undef KRD
  #undef STEP
  #undef ENDW
  {auto rr=__builtin_amdgcn_permlane32_swap(__float_as_uint(l_reg),__float_as_uint(l_reg),false,false);l_reg=__uint_as_float(rr[0])+__uint_as_float(rr[1]);}
  if(hi==0)wsf[32+r32]=l_reg;asm volatile("s_waitcnt lgkmcnt(0)":::"memory");
  float rli[16];
  #pragma unroll
  for(int r=0;r<16;++r)rli[r]=__builtin_amdgcn_rcpf(wsf[32+crow(r,hi)]);
  bf16*Ow=Ub+(rowbase+q0+wid*QBLK)*UP+h*D; const bf16*Gw=Pm+pidx(rowbase+q0+wid*QBLK,CG+h*D);
  { bf16*stg=(bf16*)(shm+LDS_OST)+wid*2048;
    #pragma unroll
    for(int r=0;r<16;++r){const int orow=crow(r,hi);
      #pragma unroll
      for(int d0=0;d0<2;++d0)stg[orow*64+d0*32+r32]=__float2bfloat16(o[d0][r]*rli[r]);}
    asm volatile("s_waitcnt lgkmcnt(0)":::"memory");
    #pragma unroll
    for(int i=0;i<4;++i){const int row=i*8+(lane>>3),ch=lane&7; const u32x4 v=*(const u32x4*)(stg+row*64+ch*8); const u32x4 gt=*(const u32x4*)(Gw+(long)row*DM+ch*8); u32x4 w;
      _Pragma("unroll") for(int e=0;e<4;++e){const float lo=__uint_as_float(v[e]<<16)*__uint_as_float(gt[e]<<16),hh=__uint_as_float(v[e]&0xffff0000u)*__uint_as_float(gt[e]&0xffff0000u); w[e]=cvtpk_s(lo,hh);}
      ATTN_STORE16(Ow+(long)row*UP+ch*8,w);} }
  asm volatile("s_waitcnt lgkmcnt(0)\n\ts_barrier":::"memory");
  #undef DMA_K
  #undef DMA_V
  #undef CMASK
  #undef START
  #undef RESC
  #undef ROT
}
constexpr int ATTN_LDS_BYTES=LDS_BYTES;
#undef SBAR
#undef WAIT_BAR
}

namespace wa {
typedef short v4i16_t __attribute__((ext_vector_type(4)));
__device__ __forceinline__ int crow(int r, int hi) { return (r & 3) + 8 * (r >> 2) + 4 * hi; }
__device__ __forceinline__ s16x4 vtr(const LAS char* p) { return __builtin_bit_cast(s16x4, __builtin_amdgcn_ds_read_tr16_b64_v4i16((LAS v4i16_t*)p)); }

template <int DH> struct State { float m, l; f32x16 o[DH / 32]; };

template <int DH, bool MASK>
__device__ __forceinline__ void tile(State<DH>& st, const bf16x8 (&qf)[DH / 16], const LAS char* kl, const LAS char* vl, int lane, int dq) {
    constexpr int NS = DH / 16, ND = DH / 32, ROWB = DH * 2 + 16;
    const int r = lane & 31, h = lane >> 5;
    const LAS char* kp = kl + r * ROWB + 16 * h;
    f32x16 S = {};
#pragma unroll
    for (int s = 0; s < NS; ++s) S = __builtin_amdgcn_mfma_f32_32x32x16_bf16(*(const LAS bf16x8*)(kp + 32 * s), qf[s], S, 0, 0, 0);
    if (MASK) {
#pragma unroll
        for (int i = 0; i < 16; ++i) { const int d = dq - crow(i, h); if (d > 64 || d < -64) S[i] = -1e30f; }
    }
    float tmax = S[0];
#pragma unroll
    for (int i = 1; i < 16; ++i) tmax = fmaxf(tmax, S[i]);
    tmax = fmaxf(tmax, __shfl_xor(tmax, 32));
    const float mnew = fmaxf(st.m, tmax), alpha = __builtin_amdgcn_exp2f(st.m - mnew);
    st.m = mnew;
    float psum = 0.f;
#pragma unroll
    for (int i = 0; i < 16; ++i) { S[i] = __builtin_amdgcn_exp2f(S[i] - mnew); psum += S[i]; }
    st.l = st.l * alpha + psum;
#pragma unroll
    for (int d = 0; d < ND; ++d)
#pragma unroll
        for (int i = 0; i < 16; ++i) st.o[d][i] *= alpha;
    u32x4 p0, p1;
    p0.x = pk2(S[0], S[1]); p0.y = pk2(S[2], S[3]); p0.z = pk2(S[4], S[5]); p0.w = pk2(S[6], S[7]);
    p1.x = pk2(S[8], S[9]); p1.y = pk2(S[10], S[11]); p1.z = pk2(S[12], S[13]); p1.w = pk2(S[14], S[15]);
    const bf16x8 pf0 = __builtin_bit_cast(bf16x8, p0), pf1 = __builtin_bit_cast(bf16x8, p1);
    const int i16 = lane & 15, q4 = i16 >> 2, p4 = i16 & 3, blk = (lane >> 4) & 1;
    const LAS char* vb = vl + (4 * h + q4) * ROWB + 32 * blk + 8 * p4;
#pragma unroll
    for (int d = 0; d < ND; ++d) {
        const s16x4 lo0 = vtr(vb + d * 64), hi0 = vtr(vb + d * 64 + 8 * ROWB), lo1 = vtr(vb + d * 64 + 16 * ROWB), hi1 = vtr(vb + d * 64 + 24 * ROWB);
        const bf16x8 v0 = __builtin_shufflevector(lo0, hi0, 0, 1, 2, 3, 4, 5, 6, 7), v1 = __builtin_shufflevector(lo1, hi1, 0, 1, 2, 3, 4, 5, 6, 7);
        st.o[d] = __builtin_amdgcn_mfma_f32_32x32x16_bf16(v0, pf0, st.o[d], 0, 0, 0);
        st.o[d] = __builtin_amdgcn_mfma_f32_32x32x16_bf16(v1, pf1, st.o[d], 0, 0, 0);
    }
}

constexpr int A_ROWB = 144, A_KROWS = 384, A_VOFF = A_KROWS * A_ROWB, A_NU = BPC * 8 * 3 * 16;
struct AUnit { int b, hh, g, dil, res, sp; };
__device__ __forceinline__ AUnit a_decode(int uid) { AUnit u; const int rs = uid & 15; u.g = (uid >> 4) % 3; u.hh = (uid / 48) & 7; u.b = uid / 384; u.dil = (u.g == 0) ? 1 : (u.g == 1) ? 4 : 16; const int spr = 16 / u.dil; u.res = rs / spr; u.sp = rs % spr; return u; }
__device__ __forceinline__ void a_load(const bf16_t* __restrict__ P, int uid, int tid, int wave, int lane, u32x4 (&kr)[6], u32x4 (&vr)[6], bf16x8 (&qn)[4]) {
    const AUnit u = a_decode(uid); const int L = SEQ / u.dil, qcol = (u.g * 8 + u.hh) * 64;
    const size_t rb = (size_t)u.b * SEQ;
#pragma unroll
    for (int it = 0; it < 6; ++it) { const int idx = tid + 512 * it, row = idx >> 3, ch = idx & 7, m = 256 * u.sp - 64 + row;
        if (m >= 0 && m < L) { const size_t rw = rb + (size_t)(m * u.dil + u.res); kr[it] = *(const u32x4*)(P + pidx(rw, C_AK + qcol + ch * 8)); vr[it] = *(const u32x4*)(P + pidx(rw, C_AV + qcol + ch * 8)); } }
    { const int r = lane & 31, h = lane >> 5, mq = 256 * u.sp + 32 * wave + r; const bf16_t* qp = P + pidx(rb + (size_t)(mq * u.dil + u.res), C_AQ + qcol + 8 * h);
#pragma unroll
      for (int s = 0; s < 4; ++s) qn[s] = *(const bf16x8*)(qp + 16 * s); }
}
__device__ __forceinline__ void mixA_phase(const bf16_t* __restrict__ P, bf16_t* OA, float* LSE, LAS char* lds, int tid, int vcu, int G) {
    const int lane = tid & 63, wave = __builtin_amdgcn_readfirstlane(tid >> 6), r = lane & 31, h = lane >> 5;
    u32x4 kr[6], vr[6]; bf16x8 qn[4];
    int uid = vcu;
    if (uid < A_NU) a_load(P, uid, tid, wave, lane, kr, vr, qn);
    for (; uid < A_NU; uid += G) {
#pragma unroll
        for (int it = 0; it < 6; ++it) { const int idx = tid + 512 * it, row = idx >> 3, ch = idx & 7; *(LAS u32x4*)(lds + row * A_ROWB + ch * 16) = kr[it]; *(LAS u32x4*)(lds + A_VOFF + row * A_ROWB + ch * 16) = vr[it]; }
        bf16x8 qf[4];
#pragma unroll
        for (int s = 0; s < 4; ++s) qf[s] = qn[s];
        __syncthreads();
        if (uid + G < A_NU) a_load(P, uid + G, tid, wave, lane, kr, vr, qn);
        const AUnit u = a_decode(uid); const int L = SEQ / u.dil, m0 = 256 * u.sp + 32 * wave;
        State<64> st; st.o[0] = f32x16{}; st.o[1] = f32x16{};
        f32x16 S[5]; bool ok[5]; float mx = -1e30f;
        const LAS char* kp = lds + (32 * wave + r) * A_ROWB + 16 * h;
#pragma unroll
        for (int j = 0; j < 5; ++j) {
            const int mk0 = m0 - 64 + 32 * j; ok[j] = (mk0 >= 0 && mk0 < L);
            if (ok[j]) {
                f32x16 s_ = {};
#pragma unroll
                for (int s = 0; s < 4; ++s) s_ = __builtin_amdgcn_mfma_f32_32x32x16_bf16(*(const LAS bf16x8*)(kp + 32 * j * A_ROWB + 32 * s), qf[s], s_, 0, 0, 0);
                if (j == 0 || j == 4) {
                    const int dq = r + 64 - 32 * j;
#pragma unroll
                    for (int i = 0; i < 16; ++i) { const int d = dq - crow(i, h); if (d > 64 || d < -64) s_[i] = -1e30f; }
                }
#pragma unroll
                for (int i = 0; i < 16; ++i) mx = fmaxf(mx, s_[i]);
                S[j] = s_;
            }
        }
        mx = fmaxf(mx, __shfl_xor(mx, 32));
        float psum = 0.f;
        const int i16 = lane & 15, q4 = i16 >> 2, p4 = i16 & 3, blk = (lane >> 4) & 1;
        const LAS char* vb = lds + A_VOFF + (32 * wave + 4 * h + q4) * A_ROWB + 32 * blk + 8 * p4;
#pragma unroll
        for (int j = 0; j < 5; ++j) {
            if (ok[j]) {
                f32x16 s_ = S[j];
#pragma unroll
                for (int i = 0; i < 16; ++i) { s_[i] = __builtin_amdgcn_exp2f(s_[i] - mx); psum += s_[i]; }
                u32x4 p0, p1;
                p0.x = pk2(s_[0], s_[1]); p0.y = pk2(s_[2], s_[3]); p0.z = pk2(s_[4], s_[5]); p0.w = pk2(s_[6], s_[7]);
                p1.x = pk2(s_[8], s_[9]); p1.y = pk2(s_[10], s_[11]); p1.z = pk2(s_[12], s_[13]); p1.w = pk2(s_[14], s_[15]);
                const bf16x8 pf0 = __builtin_bit_cast(bf16x8, p0), pf1 = __builtin_bit_cast(bf16x8, p1);
                const LAS char* vj = vb + 32 * j * A_ROWB;
#pragma unroll
                for (int d = 0; d < 2; ++d) {
                    const s16x4 lo0 = vtr(vj + d * 64), hi0 = vtr(vj + d * 64 + 8 * A_ROWB), lo1 = vtr(vj + d * 64 + 16 * A_ROWB), hi1 = vtr(vj + d * 64 + 24 * A_ROWB);
                    const bf16x8 v0 = __builtin_shufflevector(lo0, hi0, 0, 1, 2, 3, 4, 5, 6, 7), v1 = __builtin_shufflevector(lo1, hi1, 0, 1, 2, 3, 4, 5, 6, 7);
                    st.o[d] = __builtin_amdgcn_mfma_f32_32x32x16_bf16(v0, pf0, st.o[d], 0, 0, 0);
                    st.o[d] = __builtin_amdgcn_mfma_f32_32x32x16_bf16(v1, pf1, st.o[d], 0, 0, 0);
                }
            }
        }
        st.m = mx; st.l = psum;
        const float lt = st.l + __shfl_xor(st.l, 32), inv = 1.f / lt;
        const size_t orow = (size_t)u.b * SEQ + (size_t)((m0 + r) * u.dil + u.res);
        LAS char* sg = lds + 2 * A_VOFF + wave * 4096;
#pragma unroll
        for (int d = 0; d < 2; ++d)
#pragma unroll
            for (int i4 = 0; i4 < 4; ++i4) { u32x2 w; w.x = pk2(st.o[d][4 * i4] * inv, st.o[d][4 * i4 + 1] * inv); w.y = pk2(st.o[d][4 * i4 + 2] * inv, st.o[d][4 * i4 + 3] * inv);
                *(LAS u32x2*)(sg + r * 128 + (((4 * d + i4) ^ (r & 7)) << 4) + 8 * h) = w; }
        if (h == 0) LSE[orow * 24 + u.g * 8 + u.hh] = st.m + __builtin_amdgcn_logf(lt);
        asm volatile("s_waitcnt lgkmcnt(0)" ::: "memory");
#pragma unroll
        for (int i = 0; i < 4; ++i) { const int row = i * 8 + (lane >> 3), ch = lane & 7;
            const u32x4 v = *(const LAS u32x4*)(sg + row * 128 + ((ch ^ (row & 7)) << 4));
            *(u32x4*)(OA + ((size_t)u.b * SEQ + (size_t)((m0 + row) * u.dil + u.res)) * 1536 + u.g * 512 + u.hh * 64 + ch * 8) = v; }
        __syncthreads();
    }
}

constexpr int M_ROWB = 272, M_VOFF = 256 * M_ROWB, M_NU = BPC * 4 * 8;
__device__ __forceinline__ void mixM_phase(const bf16_t* __restrict__ P, const bf16_t* __restrict__ KVM, bf16_t* UM, int bg0, LAS char* lds, int tid, int vcu, int G) {
    const int lane = tid & 63, wave = __builtin_amdgcn_readfirstlane(tid >> 6), r = lane & 31, h = lane >> 5;
    for (int uid = vcu; uid < M_NU; uid += G) {
        const int b = uid >> 5, hh = (uid >> 3) & 3, part = uid & 7;
        const bf16_t* Kb = KVM + (size_t)(bg0 + b) * NMEM * 1024 + hh * 128;
#pragma unroll
        for (int it = 0; it < 8; ++it) { const int idx = tid + 512 * it, row = idx >> 4, ch = idx & 15; const bf16_t* rp = Kb + (size_t)row * 1024 + ch * 8;
            const u32x4 kv = *(const u32x4*)rp, vv = *(const u32x4*)(rp + 512);
            *(LAS u32x4*)(lds + row * M_ROWB + ch * 16) = kv; *(LAS u32x4*)(lds + M_VOFF + row * M_ROWB + ch * 16) = vv; }
        __syncthreads();
        for (int t = 0; t < 2; ++t) {
            const long qrow = (long)b * SEQ + part * 512 + (wave * 2 + t) * 32 + r;
            bf16x8 qf[8];
            { const bf16_t* qp = P + pidx(qrow, C_MQ + hh * 128 + 8 * h);
#pragma unroll
              for (int s = 0; s < 8; ++s) qf[s] = *(const bf16x8*)(qp + 16 * s); }
            State<128> st; st.m = -1e30f; st.l = 0.f;
#pragma unroll
            for (int d = 0; d < 4; ++d) st.o[d] = f32x16{};
            for (int j = 0; j < 8; ++j) tile<128, false>(st, qf, lds + 32 * j * M_ROWB, lds + M_VOFF + 32 * j * M_ROWB, lane, 0);
            const float lt = st.l + __shfl_xor(st.l, 32), inv = 1.f / lt;
            const bf16_t* gp = P + pidx(qrow, C_GM + hh * 128 + 4 * h);
            bf16_t* op = UM + (size_t)qrow * 512 + hh * 128 + 4 * h;
#pragma unroll
            for (int d = 0; d < 4; ++d)
#pragma unroll
                for (int i4 = 0; i4 < 4; ++i4) { const u32x2 g = *(const u32x2*)(gp + 32 * d + 8 * i4); u32x2 w;
                    w.x = pk2(st.o[d][4 * i4] * inv * bflo(g.x), st.o[d][4 * i4 + 1] * inv * bfhi(g.x)); w.y = pk2(st.o[d][4 * i4 + 2] * inv * bflo(g.y), st.o[d][4 * i4 + 3] * inv * bfhi(g.y));
                    *(u32x2*)(op + 32 * d + 8 * i4) = w; }
        }
        __syncthreads();
    }
}
}

constexpr size_t MiB = 1u << 20;
constexpr size_t WS_ROWSS = 0;
constexpr size_t WS_BAR = 512 * 1024;
constexpr size_t WS_COSA = 1 * MiB, WS_SINA = WS_COSA + 512 * 1024;
constexpr size_t WS_COSB = 2 * MiB, WS_SINB = WS_COSB + 4096;
constexpr size_t WS_MEMN = 3 * MiB;
constexpr size_t WS_KVM = 11 * MiB;
constexpr size_t WS_WIN = 19 * MiB;
constexpr size_t WS_WMEM = 40 * MiB;
constexpr size_t WS_WBR = 42 * MiB;
constexpr size_t WS_WOUT = 45 * MiB;
constexpr size_t WS_U = 52 * MiB;
constexpr size_t WS_Y = WS_U + (size_t)3 * RC * 512 * 2;
constexpr size_t WS_H = WS_Y;
constexpr size_t WS_OA = WS_Y + (size_t)RC * 1024 * 2;
constexpr size_t WS_LSE = WS_OA + (size_t)RC * 1536 * 2;
constexpr size_t WS_P = WS_Y + (size_t)RC * 3072 * 2;
constexpr size_t WS_END = WS_P + (size_t)RC * PITCH * 2;
static_assert(WS_LSE + (size_t)RC * 24 * 4 <= WS_P, "mixer A scratch fits under Y");
static_assert(WS_WOUT + (size_t)1024 * 3072 * 2 <= WS_U && WS_WIN + (size_t)INW * 1024 * 2 <= WS_WMEM, "weight map");
static_assert(pg8::EP_P == WS_P && pg8::EP_KVM == WS_KVM && pg8::EP_COSA == WS_COSA && pg8::EP_SINA == WS_SINA && pg8::EP_COSB == WS_COSB && pg8::EP_SINB == WS_SINB, "epilogue offsets match the map");
static_assert(WS_END <= (size_t)1024 * MiB, "workspace map exceeds 4x the largest tensor");

constexpr int LDS_BYTES = 147456, MISC_OFF = 147440;
constexpr int NTHREADS = 512, NWAVES = 8;

typedef __attribute__((address_space(1))) unsigned char* gptr_t;
template <class T> __device__ __forceinline__ T* as_global(T* p) { return (T*)(__attribute__((address_space(1))) T*)p; }
struct Args { const float *p0, *p1, *p2, *p3, *p4, *p5, *p6, *p7, *p8, *p9, *p10, *p11, *p12, *p13; float* out; unsigned char* ws; double invA[32]; double invB[16]; int ph_lo, ph_hi; };
enum { I_X = 0, I_MEM, I_GPRE, I_WIN, I_BMERGE, I_QN, I_KN, I_GMEM, I_WMEMKV, I_WBRA, I_WBRB, I_WBRM, I_WOUT, I_GPOST };

__device__ __forceinline__ int sigma_inv(int n) {
    const int t = n & 255; return (n & ~255) + 128 * ((t >> 5) & 1) + 32 * ((t >> 6) & 3) + 16 * ((t >> 2) & 1) + 4 * ((t >> 3) & 3) + (t & 3);
}
__device__ __forceinline__ int sigma_inv_g(int n) {
    const int t = n & 255; return (n & ~255) + 128 * ((t >> 3) & 1) + 32 * ((t >> 6) & 3) + 16 * ((t >> 2) & 1) + 4 * ((t >> 4) & 3) + (t & 3);
}
__device__ __forceinline__ void transpose_item(const float* __restrict__ W, int N, bf16_t* WT, int ldo, int rowoff, int koff, LAS float* scr, int item, int lane, int gfrom = 0x7fffffff) {
    const int nblk = N / 32, kb = item / nblk, nb = item % nblk, k0 = 64 * kb, n0 = 32 * nb;
#pragma unroll 8
    for (int i = 0; i < 32; ++i) { const int kk = 2 * i + (lane >> 5); scr[kk * 33 + (lane & 31)] = W[(size_t)(k0 + kk) * N + n0 + (lane & 31)]; }
    asm volatile("s_waitcnt lgkmcnt(0)" ::: "memory");
    const int c = lane & 7;
#pragma unroll
    for (int j = 0; j < 4; ++j) { const int n = (lane >> 3) + 8 * j; const LAS float* s = scr + (8 * c) * 33 + n;
        u32x4 o; o.x = pk2(s[0 * 33], s[1 * 33]); o.y = pk2(s[2 * 33], s[3 * 33]); o.z = pk2(s[4 * 33], s[5 * 33]); o.w = pk2(s[6 * 33], s[7 * 33]);
        const int nn = n0 + n; *(u32x4*)(WT + (size_t)(rowoff + (nn >= gfrom ? sigma_inv_g(nn) : sigma_inv(nn))) * ldo + koff + k0 + 8 * c) = o; }
    asm volatile("s_waitcnt lgkmcnt(0)" ::: "memory");
}
__device__ __forceinline__ float wave_sum(float v) {
#pragma unroll
    for (int o = 1; o < 64; o <<= 1) v += __shfl_xor(v, o);
    return v;
}
__device__ __forceinline__ void rms_row_to_bf16(const float* __restrict__ xrow, const float* __restrict__ g, bf16_t* orow, int lane) {
    const f32x4* xr = (const f32x4*)xrow + lane; const f32x4* gr = (const f32x4*)g + lane;
    f32x4 v[4]; float s = 0.f;
#pragma unroll
    for (int j = 0; j < 4; ++j) { v[j] = xr[64 * j]; s += (v[j].x * v[j].x + v[j].y * v[j].y) + (v[j].z * v[j].z + v[j].w * v[j].w); }
    const float rstd = rsqrtf(wave_sum(s) * (1.f / 1024.f) + NORM_EPS);
    u32x2* o8 = (u32x2*)orow + lane;
#pragma unroll
    for (int j = 0; j < 4; ++j) { const f32x4 gg = gr[64 * j]; u32x2 w; w.x = pk2(v[j].x * rstd * gg.x, v[j].y * rstd * gg.y); w.y = pk2(v[j].z * rstd * gg.z, v[j].w * rstd * gg.w); o8[64 * j] = w; }
}
__device__ __forceinline__ void sincos_d(double ang, float& c, float& s) {
    const double n = rint(ang * 0.63661977236758134308);
    double y = fma(-n, 1.5707963267948966, ang); y = fma(-n, 6.123233995736766e-17, y);
    const int q = ((int)n) & 3; const double y2 = y * y;
    const double sy = y + y * y2 * (-1.0 / 6 + y2 * (1.0 / 120 + y2 * (-1.0 / 5040 + y2 * (1.0 / 362880 + y2 * (-1.0 / 39916800 + y2 * (1.0 / 6227020800.0))))));
    const double cy = 1.0 + y2 * (-0.5 + y2 * (1.0 / 24 + y2 * (-1.0 / 720 + y2 * (1.0 / 40320 + y2 * (-1.0 / 3628800 + y2 * (1.0 / 479001600.0))))));
    const double cc = (q == 0) ? cy : (q == 1) ? -sy : (q == 2) ? -cy : sy;
    const double ss = (q == 0) ? sy : (q == 1) ? cy : (q == 2) ? -sy : -cy;
    c = (float)cc; s = (float)ss;
}

typedef __attribute__((address_space(1))) unsigned gu32;
#define XB_TMO      128
#define XB_XCNT(j)  (256  + 64 * (j))
#define XB_XSUB(j)  (1280 + 64 * (j))
#define XB_XGEN(j)  (2304 + 64 * (j))
#define XB_TOP      3328
#define XB_TOPGEN   3392
#define XCD_BAR_WORDS 3456
#define XB_SPIN_CAP (1u << 18)

__device__ __forceinline__ unsigned xb_ld(unsigned* p)              { return __hip_atomic_load(p, __ATOMIC_RELAXED, __HIP_MEMORY_SCOPE_AGENT); }
__device__ __forceinline__ unsigned xb_add(unsigned* p, unsigned v) { return __hip_atomic_fetch_add(p, v, __ATOMIC_RELAXED, __HIP_MEMORY_SCOPE_AGENT); }
__device__ __forceinline__ unsigned xb_xcc_id() { return (unsigned)__builtin_amdgcn_s_getreg((3 << 11) | 20) & 0xFu; }
#define XB_SPIN(cond, bar) do { unsigned _sp = 0; while (cond) { __builtin_amdgcn_s_sleep(1); \
    if ((++_sp & 255u) == 0u) { if (xb_ld(&(bar)[XB_TMO])) break; if (_sp > XB_SPIN_CAP) { atomicAdd(&(bar)[XB_TMO], 1u); break; } } } } while (0)

struct XcdBarrier {
    unsigned* bar; unsigned x;
    volatile LAS unsigned* st;
};

__device__ __forceinline__ XcdBarrier xcd_barrier_post(unsigned* bar, volatile LAS unsigned* st) {
    XcdBarrier b; b.bar = bar; b.x = xb_xcc_id(); b.st = st;
    if (threadIdx.x == 0) (void)xb_add(&bar[XB_XCNT(b.x)], 1u);
    return b;
}
__device__ __forceinline__ void xcd_barrier_complete(unsigned* bar, unsigned x, unsigned& nloc, unsigned& nx) {
    const unsigned G = gridDim.x * gridDim.y * gridDim.z;
    unsigned sum, cnt, mine, sp = 0u;
    for (;;) {
        sum = 0u; cnt = 0u; mine = 0u;
#pragma unroll
        for (unsigned j = 0; j < 16; ++j) { const unsigned c = xb_ld(&bar[XB_XCNT(j)]); sum += c; cnt += (c > 0u) ? 1u : 0u; mine = (j == x) ? c : mine; }
        if (sum == G) break;
        __builtin_amdgcn_s_sleep(1);
        if ((++sp & 255u) == 0u) { if (xb_ld(&bar[XB_TMO])) break; if (sp > XB_SPIN_CAP) { atomicAdd(&bar[XB_TMO], 1u); break; } }
    }
    nloc = mine > 0u ? mine : 1u; nx = cnt > 0u ? cnt : 1u;
}

__device__ __forceinline__ void xcd_barrier(const XcdBarrier& b) {
    asm volatile("s_waitcnt vmcnt(0)" ::: "memory");
    __syncthreads();
    if (threadIdx.x == 0) {
        unsigned* bar = b.bar;
        __builtin_amdgcn_s_waitcnt(0);
        unsigned nloc = b.st[0], nx = b.st[1];
        if (nloc == 0u) { xcd_barrier_complete(bar, b.x, nloc, nx); b.st[0] = nloc; b.st[1] = nx; }
        const unsigned old = xb_add(&bar[XB_XSUB(b.x)], 1u);
        const unsigned gen = old / nloc;
        if (old + 1u == (gen + 1u) * nloc) {
            __builtin_amdgcn_fence(__ATOMIC_RELEASE, "agent");
            asm volatile("s_waitcnt vmcnt(0)" ::: "memory");
            const unsigned og = xb_add(&bar[XB_TOP], 1u);
            const unsigned tg = og / nx;
            if (og + 1u == (tg + 1u) * nx) xb_add(&bar[XB_TOPGEN], 1u);
            else XB_SPIN(xb_ld(&bar[XB_TOPGEN]) == tg, bar);
            __builtin_amdgcn_fence(__ATOMIC_ACQUIRE, "agent");
            xb_add(&bar[XB_XGEN(b.x)], 1u);
            asm volatile("s_waitcnt vmcnt(0)" ::: "memory");
        } else {
            XB_SPIN(xb_ld(&bar[XB_XGEN(b.x)]) == gen, bar);
            __builtin_amdgcn_fence(__ATOMIC_ACQUIRE, "agent");
            asm volatile("s_waitcnt vmcnt(0)" ::: "memory");
        }
    }
    __syncthreads();
}

__global__ void __launch_bounds__(NTHREADS, 2) mega_fwd(Args a) {
    extern __shared__ __attribute__((aligned(16))) unsigned char lds[];
    cg::grid_group grid = cg::this_grid();
    unsigned* const barw = (unsigned*)(a.ws + WS_BAR);
    { LAS unsigned* misc = (LAS unsigned*)((LAS unsigned char*)lds + MISC_OFF); if (threadIdx.x < 4) misc[threadIdx.x] = 0u;
      if (blockIdx.x == 0) for (int i = threadIdx.x; i < XCD_BAR_WORDS; i += NTHREADS) barw[i] = 0u;
      __syncthreads(); }
    XcdBarrier xb; xb.bar = barw; xb.x = 0; xb.st = nullptr;
#define IN(k) true
#define SEAM(k) do { gptr_t b_ = (gptr_t)a.ws; asm volatile("" : "+s"(b_)); xb.bar = (unsigned*)((unsigned char*)b_ + WS_BAR); xcd_barrier(xb); } while (0)
#define PHASE_VARS() \
    int tid = threadIdx.x; asm volatile("" : "+v"(tid)); gptr_t wsg_ = (gptr_t)a.ws; asm volatile("" : "+s"(wsg_)); unsigned char* ws = (unsigned char*)wsg_; const float* const in_[14] = {a.p0, a.p1, a.p2, a.p3, a.p4, a.p5, a.p6, a.p7, a.p8, a.p9, a.p10, a.p11, a.p12, a.p13}; (void)in_; \
    const int lane = tid & 63, wave = __builtin_amdgcn_readfirstlane(tid >> 6); \
    const int G = gridDim.x, bx = blockIdx.x, vcu = (G % 8 == 0) ? (bx % 8) * (G / 8) + bx / 8 : bx; \
    const int gw = vcu * NWAVES + wave, NGW = G * NWAVES; (void)gw; (void)NGW; (void)lane; (void)vcu; \
    LAS unsigned char* ldsl = (LAS unsigned char*)lds; (void)ldsl

    if (IN(0)) {
        PHASE_VARS();
        float* rowss = (float*)(ws + WS_ROWSS);
        float* cosA = (float*)(ws + WS_COSA); float* sinA = (float*)(ws + WS_SINA); float* cosB = (float*)(ws + WS_COSB); float* sinB = (float*)(ws + WS_SINB);
        bf16_t* MEMN = (bf16_t*)(ws + WS_MEMN); bf16_t* WIN = (bf16_t*)(ws + WS_WIN); bf16_t* WMEM = (bf16_t*)(ws + WS_WMEM); bf16_t* WBR = (bf16_t*)(ws + WS_WBR); bf16_t* WOUT = (bf16_t*)(ws + WS_WOUT);
        bf16_t* H = (bf16_t*)(ws + WS_H);
        LAS float* scr = (LAS float*)(ldsl + wave * 16384);
        constexpr int I_IN = (1024 / 64) * (INW / 32), I_MK = (1024 / 64) * (1024 / 32), I_BR = (512 / 64) * (1024 / 32), I_O = (1024 / 64) * (1024 / 32);
        constexpr int NITEMS = I_IN + I_MK + 3 * I_BR + I_O;
        for (int it = gw; it < NITEMS; it += NGW) {
            int r = it;
            if (r < I_IN) { transpose_item(in_[I_WIN], INW, WIN, 1024, 0, 0, scr, r, lane); continue; } r -= I_IN;
            if (r < I_MK) { transpose_item(in_[I_WMEMKV], 1024, WMEM, 1024, 0, 0, scr, r, lane); continue; } r -= I_MK;
            if (r < I_BR) { transpose_item(in_[I_WBRA], 1024, WBR, 512, 0, 0, scr, r, lane); continue; } r -= I_BR;
            if (r < I_BR) { transpose_item(in_[I_WBRB], 1024, WBR, 512, 1024, 0, scr, r, lane); continue; } r -= I_BR;
            if (r < I_BR) { transpose_item(in_[I_WBRM], 1024, WBR, 512, 2048, 0, scr, r, lane); continue; } r -= I_BR;
            transpose_item(in_[I_WOUT], 1024, WOUT, 1024, 0, 0, scr, r, lane);
        }
        for (int i = bx * NTHREADS + tid; i < SEQ * 32; i += G * NTHREADS) { float c, s; sincos_d((double)(i >> 5) * a.invA[i & 31], c, s); cosA[i] = c; sinA[i] = s; }
        for (int i = bx * NTHREADS + tid; i < 64 * 16; i += G * NTHREADS) { float c, s; sincos_d((double)(i >> 4) * a.invB[i & 15], c, s); cosB[i] = c; sinB[i] = s; }
        for (int i = bx * NTHREADS + tid; i < MTOT; i += G * NTHREADS) rowss[i] = 0.f;
        for (int m = gw; m < BATCH * NMEM; m += NGW) rms_row_to_bf16(in_[I_MEM] + (size_t)m * 1024, in_[I_GMEM], MEMN + (size_t)m * 1024, lane);
        for (int m = gw; m < RC; m += NGW) rms_row_to_bf16(in_[I_X] + (size_t)m * 1024, in_[I_GPRE], H + (size_t)m * 1024, lane);
    }
    grid.sync();
    xb = xcd_barrier_post(barw, (volatile LAS unsigned*)((LAS unsigned char*)lds + MISC_OFF));

    for (int c = 0; c < NCH; ++c) {
        const int pb = 1 + 6 * c;
        const size_t grow0 = (size_t)c * RC;

        if (IN(pb)) {
            PHASE_VARS();
            pg8::Sched S; S.nM = RC / 256; S.nN = INW / 256; S.nwg = S.nM * S.nN; S.nX = (c == 0) ? (BATCH * NMEM / 256) * 4 : 0; S.G = G; S.c = bx; S.seg3 = 0;
            S.A = (const char*)(ws + WS_H); S.B = (const char*)(ws + WS_WIN); S.A2 = (const char*)(ws + WS_MEMN); S.B2 = (const char*)(ws + WS_WMEM); S.tsA = (size_t)256 * 1024 * 2; S.tsB = (size_t)256 * 1024 * 2; S.grpStride = 0; S.grpShift = 31;
            pg8::EpiP1 E{ws, in_[I_BMERGE], in_[I_QN], in_[I_KN]};
            pg8::gemm_phase<pg8::EpiP1, pg8::Sched, true, true>(ldsl, 1024, S, E);
        }
        SEAM(pb);

        if (IN(pb + 1)) {
            PHASE_VARS();
            const bf16_t* P = (const bf16_t*)(ws + WS_P); bf16_t* U = (bf16_t*)(ws + WS_U); bf16_t* OA = (bf16_t*)(ws + WS_OA); float* LSE = (float*)(ws + WS_LSE);
            const int rcls = vcu & 3; int nb = 0, uid = vcu;
            for (; uid < BPC * 8 * 16 && nb < rcls; uid += G, ++nb) {
                const int pair = uid >> 6, sub = uid & 63, b = pair >> 1, h = (pair & 1) * 4 + (sub >> 4), qb = sub & 15;
                attn_body::attn_unit<8>((long)b * SEQ, h, qb, (const attn_body::bf16*)P, (attn_body::bf16*)(U + (size_t)RC * 512), (char*)lds);
            }
            __syncthreads();
            wa::mixA_phase(P, OA, LSE, (LAS char*)ldsl, tid, vcu, G);
            for (; uid < BPC * 8 * 16; uid += G) {
                const int pair = uid >> 6, sub = uid & 63, b = pair >> 1, h = (pair & 1) * 4 + (sub >> 4), qb = sub & 15;
                attn_body::attn_unit<8>((long)b * SEQ, h, qb, (const attn_body::bf16*)P, (attn_body::bf16*)(U + (size_t)RC * 512), (char*)lds);
            }
            __syncthreads();
        }
        if (IN(pb + 1)) {
            PHASE_VARS();
            const bf16_t* P = (const bf16_t*)(ws + WS_P); bf16_t* U = (bf16_t*)(ws + WS_U); const bf16_t* KVM = (const bf16_t*)(ws + WS_KVM);
            wa::mixM_phase(P, KVM, U + (size_t)2 * RC * 512, c * BPC, (LAS char*)ldsl, tid, vcu, G);
        }
        SEAM(pb + 1);
        if (IN(pb + 2)) {
            PHASE_VARS();
            const bf16_t* P = (const bf16_t*)(ws + WS_P); bf16_t* U = (bf16_t*)(ws + WS_U); const bf16_t* OA = (const bf16_t*)(ws + WS_OA); const float* LSE = (const float*)(ws + WS_LSE);
            for (int idx = bx * NTHREADS + tid; idx < RC * 64; idx += G * NTHREADS) {
                const int row = idx >> 6, c8 = idx & 63, hh = c8 >> 3;
                const float l0 = LSE[(size_t)row * 24 + hh], l1 = LSE[(size_t)row * 24 + 8 + hh], l2 = LSE[(size_t)row * 24 + 16 + hh];
                const float mx = fmaxf(l0, fmaxf(l1, l2));
                float w0 = __builtin_amdgcn_exp2f(l0 - mx), w1 = __builtin_amdgcn_exp2f(l1 - mx), w2 = __builtin_amdgcn_exp2f(l2 - mx);
                const float inv = 1.f / (w0 + w1 + w2); w0 *= inv; w1 *= inv; w2 *= inv;
                const bf16_t* op = OA + (size_t)row * 1536 + c8 * 8;
                const u32x4 o0 = *(const u32x4*)op, o1 = *(const u32x4*)(op + 512), o2 = *(const u32x4*)(op + 1024), gt = *(const u32x4*)(P + pidx(row, C_GA + c8 * 8));
                u32x4 w;
#pragma unroll
                for (int e = 0; e < 4; ++e) { const float vlo = (w0 * bflo(o0[e]) + w1 * bflo(o1[e]) + w2 * bflo(o2[e])) * bflo(gt[e]), vhi = (w0 * bfhi(o0[e]) + w1 * bfhi(o1[e]) + w2 * bfhi(o2[e])) * bfhi(gt[e]); w[e] = pk2(vlo, vhi); }
                *(u32x4*)(U + (size_t)row * 512 + c8 * 8) = w;
            }
        }
        SEAM(pb + 2);

        if (IN(pb + 3)) {
            PHASE_VARS();
            pg8::Sched S; S.nM = RC / 256; S.nN = 4; S.nwg = S.nM * S.nN; S.nX = 0; S.G = G; S.c = bx; S.seg3 = 1;
            S.A = (const char*)(ws + WS_U); S.B = (const char*)(ws + WS_WBR); S.A2 = S.A; S.B2 = S.B; S.tsA = (size_t)256 * 512 * 2; S.tsB = (size_t)256 * 512 * 2; S.grpStride = (size_t)RC * 512 * 2; S.grpShift = 2;
            pg8::EpiBr E{(const bf16_t*)(ws + WS_P), (bf16_t*)(ws + WS_Y)};
            pg8::gemm_phase<pg8::EpiBr, pg8::Sched, true, true>(ldsl, 512, S, E);
        }
        SEAM(pb + 3);

        if (IN(pb + 4)) {
            PHASE_VARS();
            pg8::Sched S; S.nM = RC / 256; S.nN = 4; S.nwg = S.nM * S.nN; S.nX = 0; S.G = G; S.c = bx; S.seg3 = 0;
            S.A = (const char*)(ws + WS_Y); S.B = (const char*)(ws + WS_WOUT); S.A2 = S.A; S.B2 = S.B; S.tsA = (size_t)256 * 1024 * 2; S.tsB = (size_t)256 * 1024 * 2; S.grpStride = 0; S.grpShift = 31;
            pg8::EpiOut E{a.out + grow0 * 1024, (float*)(ws + WS_ROWSS) + grow0};
            pg8::gemm_phase<pg8::EpiOut, pg8::Sched, true, true>(ldsl, 1024, S, E);
        }
        SEAM(pb + 4);

        if (IN(pb + 5)) {
            PHASE_VARS();
            const float* gpost = in_[I_GPOST]; const float* rowss = (const float*)(ws + WS_ROWSS); bf16_t* H = (bf16_t*)(ws + WS_H);
            for (int m = gw; m < RC; m += NGW) {
                const size_t row = grow0 + m; const float rstd = rsqrtf(rowss[row] * (1.f / 1024.f) + NORM_EPS);
                const f32x4* xr = (const f32x4*)(in_[I_X] + row * 1024) + lane; f32x4* orp = (f32x4*)(a.out + row * 1024) + lane; const f32x4* gr = (const f32x4*)gpost + lane;
                const u32x2* pr = (const u32x2*)(a.out + row * 1024) + lane;
                u32x2 pv[4];
#pragma unroll
                for (int j = 0; j < 4; ++j) pv[j] = __builtin_nontemporal_load(pr + 64 * j);
                asm volatile("s_waitcnt vmcnt(0)" ::: "memory");
#pragma unroll
                for (int j = 0; j < 4; ++j) { const f32x4 o = {bflo(pv[j].x), bfhi(pv[j].x), bflo(pv[j].y), bfhi(pv[j].y)}; __builtin_nontemporal_store(__builtin_nontemporal_load(xr + 64 * j) + o * rstd * gr[64 * j], orp + 64 * j); }
            }
            if (c + 1 < NCH) for (int m = gw; m < RC; m += NGW) rms_row_to_bf16(in_[I_X] + (grow0 + RC + m) * 1024, in_[I_GPRE], H + (size_t)m * 1024, lane);
        }
        if (c + 1 < NCH) SEAM(pb + 5);
    }
#undef IN
#undef SEAM
#undef PHASE_VARS
}

constexpr int N_PHASES = 1 + 6 * NCH;
extern "C" void kernel_launch(void* const* d_in, const int* in_sizes, int n_in, void* d_out, int out_size, void* d_ws, size_t ws_size, hipStream_t stream) {
    static int grid = 0;
    if (grid == 0) {
        if (n_in != 14 || in_sizes[0] != MTOT * 1024 || out_size != MTOT * 1024 || ws_size < WS_END) { fprintf(stderr, "kernel_launch: unexpected shapes (n_in %d, ws %zu, need %zu); nothing launched\n", n_in, ws_size, (size_t)WS_END); grid = -1; return; }
        int dev = 0, cus = 0, per_cu = 0;
        (void)hipGetDevice(&dev); (void)hipDeviceGetAttribute(&cus, hipDeviceAttributeMultiprocessorCount, dev);
        if (hipFuncSetAttribute((const void*)mega_fwd, hipFuncAttributeMaxDynamicSharedMemorySize, LDS_BYTES) != hipSuccess) { fprintf(stderr, "kernel_launch: hipFuncSetAttribute failed\n"); grid = -1; return; }
        if (hipOccupancyMaxActiveBlocksPerMultiprocessor(&per_cu, (const void*)mega_fwd, NTHREADS, LDS_BYTES) != hipSuccess || per_cu < 1) { fprintf(stderr, "kernel_launch: occupancy query reports %d\n", per_cu); per_cu = 1; }
        (void)hipGetLastError();
        grid = cus;
        if (grid > cus * per_cu) grid = cus * per_cu;
    }
    if (grid < 0) return;
    Args a{};
    { const float** pp = &a.p0; for (int i = 0; i < 14; ++i) pp[i] = (const float*)d_in[i]; }
    a.out = (float*)d_out; a.ws = (unsigned char*)d_ws;
    for (int i = 0; i < 32; ++i) a.invA[i] = pow(10000.0, -(double)i / 32.0);
    for (int i = 0; i < 16; ++i) a.invB[i] = pow(10000.0, -(double)i / 16.0);
    a.ph_lo = 0; a.ph_hi = N_PHASES;
    void* args[] = {&a};
    hipError_t e = hipLaunchCooperativeKernel((const void*)mega_fwd, dim3(grid), dim3(NTHREADS), args, LDS_BYTES, stream);
    if (e != hipSuccess) fprintf(stderr, "cooperative launch failed: %s (grid %d)\n", hipGetErrorString(e), grid);
}
```

```cpp
#include <hip/hip_runtime.h>
#include <hip/hip_cooperative_groups.h>
#include <hip/hip_bf16.h>
#include <cstdio>
#include <cstdint>
#include <cmath>
namespace cg = cooperative_groups;

#define LAS __attribute__((address_space(3)))
typedef unsigned short bf16_t;
typedef short bf16x8 __attribute__((ext_vector_type(8)));
typedef short s16x4 __attribute__((ext_vector_type(4)));
typedef float f32x2 __attribute__((ext_vector_type(2)));
typedef float f32x4 __attribute__((ext_vector_type(4)));
typedef float f32x16 __attribute__((ext_vector_type(16)));
typedef unsigned u32x2 __attribute__((ext_vector_type(2)));
typedef unsigned u32x4 __attribute__((ext_vector_type(4)));
typedef __bf16 bf16x2_t __attribute__((ext_vector_type(2)));

constexpr int BATCH = 16, SEQ = 4096, DM_ = 1024, MTOT = BATCH * SEQ;
constexpr int NCH = 2, BPC = BATCH / NCH, RC = BPC * SEQ;
constexpr int INW = 10496, PITCH = INW;
constexpr int C_AQ = 0, C_AK = 1536, C_AV = 3072, C_BQ = 4608, C_BK = 5120, C_BV = 5248, C_MQ = 5376, C_GA = 5888, C_GB = 6400, C_GM = 6912, C_MG = 7424;
constexpr int NMEM = 256;
constexpr size_t PTILE = (size_t)RC * 256;
__host__ __device__ __forceinline__ size_t pidx(size_t row, int col) { return (size_t)(col >> 8) * PTILE + row * 256 + (size_t)(col & 255); }
constexpr float LOG2E = 1.4426950408889634f;
constexpr float QS_A = 0.125f * LOG2E;
constexpr float QS_M = 0.08838834764831845f * LOG2E;
constexpr float NORM_EPS = 1e-6f;

__device__ __forceinline__ unsigned pk2(float lo, float hi) { f32x2 v = {lo, hi}; bf16x2_t b = __builtin_convertvector(v, bf16x2_t); return __builtin_bit_cast(unsigned, b); }
__device__ __forceinline__ float bflo(unsigned w) { return __uint_as_float(w << 16); }
__device__ __forceinline__ float bfhi(unsigned w) { return __uint_as_float(w & 0xffff0000u); }

namespace pg8 {
#define PG8_LAS __attribute__((address_space(3)))
constexpr int BM = 256, BK = 64, HALF = 128, HTB = HALF * BK * 2, STAGE_BYTES = 8 * HTB, NXCD = 8, WGM = 8;
__host__ __device__ __forceinline__ int lds_byte(int r, int c) { const int st = (r >> 4) * 2 + (c >> 5), rr = r & 15, cc = c & 31, ob = rr * 64 + cc * 2; return st * 1024 + (ob ^ (((ob >> 9) & 1) << 5)); }
__host__ __device__ __forceinline__ void stage_rc(int b, int& R, int& C) { const int st = b / 1024, sb = b % 1024, swz = sb ^ (((sb >> 9) & 1) << 5); R = (st >> 1) * 16 + swz / 64; C = (st & 1) * 32 + (swz % 64) / 2; }

struct Unit { int pm, pn, kind; };
struct Sched {
    int nM, nN, nwg, nX, G, c, seg3;
    const char *A, *B, *A2, *B2; size_t tsA, tsB, grpStride; int grpShift;
    __device__ __forceinline__ bool next(int i, Unit& u) const {
        const int seg = seg3 ? i % 3 : 0; if (seg3) i /= 3;
        int L = i * G + c; asm volatile("" : "+s"(L)); if (L >= nwg + nX) return false;
        if (L >= nwg) { const int e = L - nwg; u.pm = e >> 2; u.pn = e & 3; u.kind = 1; return true; }
        int wgid = L; { const int q = nwg / NXCD, r = nwg % NXCD, xcd = wgid % NXCD, off = wgid / NXCD; wgid = (xcd < r ? xcd * (q + 1) : r * (q + 1) + (xcd - r) * q) + off; }
        const int nig = WGM * nN, gid = wgid / nig, fm = gid * WGM, gsz = (nM - fm) < WGM ? (nM - fm) : WGM;
        u.pm = fm + ((wgid % nig) % gsz); u.pn = (wgid % nig) / gsz + 4 * seg; u.kind = 0; return true;
    }
    __device__ __forceinline__ const char* aptr(const Unit& u) const { return u.kind ? A2 + (size_t)u.pm * tsA : A + (size_t)(u.pn >> grpShift) * grpStride + (size_t)u.pm * tsA; }
    __device__ __forceinline__ const char* bptr(const Unit& u) const { return (u.kind ? B2 : B) + (size_t)u.pn * tsB; }
};
template <class Epi, class Sched, bool ALIGN_EPI = false, bool SP2 = false>
__device__ __forceinline__ void gemm_phase(PG8_LAS unsigned char* lds, const int K, const Sched& S, const Epi& E) {
    int tid_ = threadIdx.x; asm volatile("" : "+v"(tid_)); const int tid = tid_, wid = __builtin_amdgcn_readfirstlane(tid >> 6), lane = tid & 63, wr = wid >> 2, wc = wid & 3, fr = lane & 15, fq = lane >> 4;
    const int nt = K / BK;
    unsigned voffA[2], voffB[2];
#pragma unroll
    for (int i = 0; i < 2; ++i) { int R, C; stage_rc(tid * 16 + i * 8192, R, C); const int Rb = R;
        voffA[i] = (unsigned)(R * K + C) * 2u; voffB[i] = (unsigned)(Rb * K + C) * 2u; }
    const size_t kstep = (size_t)(BK * 2);
    const size_t hstep = (size_t)HALF * K * 2;
    const unsigned ldsw = (unsigned)wid * 1024u;
    const int aoff = lds_byte(wr * 64 + fr, fq * 8), boff = lds_byte(wc * 32 + fr, fq * 8);
#define PG8_SA(b, h) (((b) * 2 + (h)) * HTB)
#define PG8_SB(b, h) ((4 + (b) * 2 + (h)) * HTB)
#define PG8_STAGE(bufoff, gbase, voff) do { _Pragma("unroll") for (int _i = 0; _i < 2; ++_i) \
        __builtin_amdgcn_global_load_lds((const unsigned*)((const char*)(gbase) + (voff)[_i]), (PG8_LAS unsigned*)(lds + (bufoff) + ldsw + _i * 8192), 16, 0, 0); } while (0)
#define PG8_LDA(dst, b, h) do { _Pragma("unroll") for (int m = 0; m < 4; ++m) _Pragma("unroll") for (int k = 0; k < 2; ++k) dst[m][k] = *(const PG8_LAS bf16x8*)(lds + PG8_SA(b, h) + aoff + m * 2048 + k * 1024); } while (0)
#define PG8_LDB(dst, b, h) do { _Pragma("unroll") for (int n = 0; n < 2; ++n) _Pragma("unroll") for (int k = 0; k < 2; ++k) dst[n][k] = *(const PG8_LAS bf16x8*)(lds + PG8_SB(b, h) + boff + n * 2048 + k * 1024); } while (0)
#define PG8_MMA(ai, bj, At, Bt) do { __builtin_amdgcn_s_setprio(1); _Pragma("unroll") for (int m = 0; m < 4; ++m) _Pragma("unroll") for (int n = 0; n < 2; ++n) _Pragma("unroll") for (int k = 0; k < 2; ++k) \
        acc[ai][bj][m][n] = __builtin_amdgcn_mfma_f32_16x16x32_bf16(Bt[n][k], At[m][k], acc[ai][bj][m][n], 0, 0, 0); __builtin_amdgcn_s_setprio(0); } while (0)
#define PG8_WAIT_V(n) asm volatile("s_waitcnt vmcnt(" #n ")" ::: "memory")
#define PG8_WAIT_L(n) asm volatile("s_waitcnt lgkmcnt(" #n ")" ::: "memory")
#define PG8_BAR __builtin_amdgcn_s_barrier()
#define PG8_SCHED __builtin_amdgcn_sched_barrier(0)
    Unit cur, nxt; int ui = 0;
    if (!S.next(0, cur)) return;
    f32x4 acc[2][2][4][2];
#pragma unroll
    for (int a = 0; a < 2; ++a)
#pragma unroll
        for (int b = 0; b < 2; ++b)
#pragma unroll
            for (int m = 0; m < 4; ++m)
#pragma unroll
                for (int n = 0; n < 2; ++n) acc[a][b][m][n] = (f32x4){0.f, 0.f, 0.f, 0.f};
    bf16x8 At[4][2], B0[2][2], B1[2][2];
    const char* cA = S.aptr(cur); const char* cB = S.bptr(cur);
    if constexpr (SP2) {
        PG8_STAGE(PG8_SB(0, 0), cB, voffB); PG8_STAGE(PG8_SB(0, 1), cB + hstep, voffB); PG8_STAGE(PG8_SA(0, 0), cA, voffA); PG8_STAGE(PG8_SA(0, 1), cA + hstep, voffA);
        if (wr == 1) PG8_BAR;
        PG8_WAIT_V(2); PG8_BAR;
        PG8_STAGE(PG8_SB(1, 0), cB + kstep, voffB); PG8_STAGE(PG8_SA(1, 0), cA + kstep, voffA); PG8_STAGE(PG8_SB(1, 1), cB + hstep + kstep, voffB);
        PG8_WAIT_V(6); PG8_BAR;
    } else {
        PG8_STAGE(PG8_SB(0, 0), cB, voffB); PG8_STAGE(PG8_SA(0, 0), cA, voffA); PG8_STAGE(PG8_SB(0, 1), cB + hstep, voffB); PG8_STAGE(PG8_SA(0, 1), cA + hstep, voffA);
        if (wr == 1) PG8_BAR;
        PG8_WAIT_V(4); PG8_BAR;
        PG8_STAGE(PG8_SB(1, 0), cB + kstep, voffB); PG8_STAGE(PG8_SA(1, 0), cA + kstep, voffA); PG8_STAGE(PG8_SB(1, 1), cB + hstep + kstep, voffB);
        PG8_WAIT_V(6); PG8_BAR;
    }
    for (;;) {
        const bool has_next = S.next(ui + 1, nxt);
        const char* nA = has_next ? S.aptr(nxt) : cA; const char* nB = has_next ? S.bptr(nxt) : cB;
        for (int t = 0; t < nt; t += 2) {
            const bool last = (t == nt - 2);
            const char* a1 = cA + (size_t)(t + 1) * kstep;
            const char* a2 = last ? nA : cA + (size_t)(t + 2) * kstep; const char* b2 = last ? nB : cB + (size_t)(t + 2) * kstep;
            const char* a3 = a2 + kstep; const char* b3 = b2 + kstep;
            if constexpr (SP2) {
            PG8_LDB(B0, 0, 0); PG8_LDB(B1, 0, 1); PG8_SCHED; PG8_LDA(At, 0, 0); PG8_STAGE(PG8_SA(1, 1), a1 + hstep, voffA);
            PG8_WAIT_V(8); PG8_WAIT_L(0); PG8_BAR; PG8_MMA(0, 0, At, B0); PG8_MMA(0, 1, At, B1); PG8_BAR; PG8_SCHED;
            PG8_LDA(At, 0, 1); PG8_STAGE(PG8_SB(0, 0), b2, voffB); PG8_STAGE(PG8_SB(0, 1), b2 + hstep, voffB); PG8_STAGE(PG8_SA(0, 0), a2, voffA);
            PG8_WAIT_V(8); PG8_WAIT_L(0); PG8_BAR; PG8_MMA(1, 0, At, B0); PG8_MMA(1, 1, At, B1); PG8_BAR; PG8_SCHED;
            PG8_LDB(B0, 1, 0); PG8_LDB(B1, 1, 1); PG8_SCHED; PG8_LDA(At, 1, 0); PG8_STAGE(PG8_SA(0, 1), a2 + hstep, voffA);
            PG8_WAIT_V(8); PG8_WAIT_L(0); PG8_BAR; PG8_MMA(0, 0, At, B0); PG8_MMA(0, 1, At, B1); PG8_BAR; PG8_SCHED;
            PG8_LDA(At, 1, 1); PG8_STAGE(PG8_SB(1, 0), b3, voffB); PG8_STAGE(PG8_SB(1, 1), b3 + hstep, voffB); PG8_STAGE(PG8_SA(1, 0), a3, voffA);
            PG8_WAIT_V(8); PG8_WAIT_L(0); PG8_BAR; PG8_MMA(1, 0, At, B0); PG8_MMA(1, 1, At, B1); PG8_BAR; PG8_SCHED;
            } else {
            PG8_LDB(B0, 0, 0); PG8_SCHED; PG8_LDA(At, 0, 0); PG8_STAGE(PG8_SA(1, 1), a1 + hstep, voffA);
            PG8_WAIT_L(8); PG8_BAR; PG8_WAIT_L(0); PG8_MMA(0, 0, At, B0); PG8_BAR; PG8_SCHED;
            PG8_LDB(B1, 0, 1); PG8_STAGE(PG8_SB(0, 0), b2, voffB);
            PG8_BAR; PG8_WAIT_L(0); PG8_MMA(0, 1, At, B1); PG8_BAR;
            PG8_LDA(At, 0, 1); PG8_STAGE(PG8_SA(0, 0), a2, voffA);
            PG8_BAR; PG8_WAIT_L(0); PG8_MMA(1, 0, At, B0); PG8_BAR; PG8_SCHED;
            PG8_STAGE(PG8_SB(0, 1), b2 + hstep, voffB);
            PG8_WAIT_V(6); PG8_BAR; PG8_MMA(1, 1, At, B1); PG8_BAR;
            PG8_LDB(B0, 1, 0); PG8_SCHED; PG8_LDA(At, 1, 0); PG8_STAGE(PG8_SA(0, 1), a2 + hstep, voffA);
            PG8_WAIT_L(8); PG8_BAR; PG8_WAIT_L(0); PG8_MMA(0, 0, At, B0); PG8_BAR; PG8_SCHED;
            PG8_LDB(B1, 1, 1); PG8_STAGE(PG8_SB(1, 0), b3, voffB);
            PG8_BAR; PG8_WAIT_L(0); PG8_MMA(0, 1, At, B1); PG8_BAR;
            PG8_LDA(At, 1, 1); PG8_STAGE(PG8_SA(1, 0), a3, voffA);
            PG8_BAR; PG8_WAIT_L(0); PG8_MMA(1, 0, At, B0); PG8_BAR; PG8_SCHED;
            PG8_STAGE(PG8_SB(1, 1), b3 + hstep, voffB);
            PG8_WAIT_V(6); PG8_BAR; PG8_MMA(1, 1, At, B1); PG8_BAR;
            }
        }
        if constexpr (ALIGN_EPI) { if (wr == 0) PG8_BAR; }
        { E(acc, cur, wr, wc, fr, fq); }
        if (!has_next) break;
#pragma unroll
        for (int a = 0; a < 2; ++a)
#pragma unroll
            for (int b = 0; b < 2; ++b)
#pragma unroll
                for (int m = 0; m < 4; ++m)
#pragma unroll
                    for (int n = 0; n < 2; ++n) acc[a][b][m][n] = (f32x4){0.f, 0.f, 0.f, 0.f};
        cur = nxt; cA = nA; cB = nB; ++ui;
        if constexpr (ALIGN_EPI) { if (wr == 1) PG8_BAR; }
    }
    PG8_WAIT_V(0);
    if constexpr (!ALIGN_EPI) { if (wr == 0) PG8_BAR; }
    PG8_BAR;
#undef PG8_SA
#undef PG8_SB
#undef PG8_STAGE
#undef PG8_LDA
#undef PG8_LDB
#undef PG8_MMA
#undef PG8_WAIT_V
#undef PG8_WAIT_L
#undef PG8_BAR
#undef PG8_SCHED
}
__device__ __forceinline__ u32x4 pack8(const f32x4 a, const f32x4 b) { u32x4 w; w.x = pk2(a[0], a[1]); w.y = pk2(a[2], a[3]); w.z = pk2(b[0], b[1]); w.w = pk2(b[2], b[3]); return w; }
__device__ __forceinline__ u32x4 xor1(u32x4 v) {
    u32x4 r;
#pragma unroll
    for (int e = 0; e < 4; ++e) r[e] = (unsigned)__builtin_amdgcn_mov_dpp((int)v[e], 0xB1, 0xF, 0xF, true);
    return r;
}
template <int PITCH_ = 256, bool NT = true>
__device__ __forceinline__ void store_pair(bf16_t* rp, int fr, const u32x4 wA, const u32x4 wB) {
    const bool odd = fr & 1;
    const u32x4 t = odd ? wA : wB, r = xor1(t);
    const u32x4 s1 = odd ? r : wA, s2 = odd ? wB : r;
    bf16_t* p1 = rp + (odd ? -PITCH_ + 32 : 0); bf16_t* p2 = rp + (odd ? 32 : PITCH_);
    if (NT) { __builtin_nontemporal_store(s1, (u32x4*)p1); __builtin_nontemporal_store(s2, (u32x4*)p2); } else { *(u32x4*)p1 = s1; *(u32x4*)p2 = s2; }
}
__device__ __forceinline__ void store8(bf16_t* p, const f32x4 a, const f32x4 b) {
    u32x4 w; w.x = pk2(a[0], a[1]); w.y = pk2(a[2], a[3]); w.z = pk2(b[0], b[1]); w.w = pk2(b[2], b[3]); __builtin_nontemporal_store(w, (u32x4*)p);
}
constexpr size_t EP_COSA = (size_t)1 << 20, EP_SINA = EP_COSA + 512 * 1024, EP_COSB = (size_t)2 << 20, EP_SINB = EP_COSB + 4096, EP_KVM = (size_t)11 << 20;
constexpr size_t EP_P = ((size_t)52 << 20) + (size_t)3 * RC * 512 * 2 + (size_t)RC * 3072 * 2;
struct EpiP1 {
    unsigned char* ws; const float* bmerge; const float* qn; const float* kn;
    __device__ __forceinline__ void operator()(const f32x4 (&acc)[2][2][4][2], const Unit& u, int wr, int wc, int fr, int fq) const {
        asm volatile("" : "+v"(fr), "+v"(fq));
        float one = 1.f; asm volatile("" : "+v"(one));
        bf16_t* const P = (bf16_t*)(ws + EP_P); bf16_t* const KVM = (bf16_t*)(ws + EP_KVM);
        const float* const cosA = (const float*)(ws + EP_COSA); const float* const sinA = (const float*)(ws + EP_SINA); const float* const cosB = (const float*)(ws + EP_COSB); const float* const sinB = (const float*)(ws + EP_SINB);
        const int row0 = u.pm * BM + wr * 64 + fr;
        if (u.kind) {
            const int col = u.pn * BM + wc * 64 + fq * 8;
#pragma unroll
            for (int ai = 0; ai < 2; ++ai)
#pragma unroll
                for (int m = 0; m < 4; ++m) { bf16_t* rp = KVM + (size_t)(row0 + ai * HALF + m * 16) * 1024 + col;
#pragma unroll
                    for (int bj = 0; bj < 2; ++bj) store8(rp + bj * 32, acc[ai][bj][m][0], acc[ai][bj][m][1]); }
            return;
        }
        const int pn = u.pn, col = pn * BM + wc * 64 + fq * 8;
        int type;
        if (pn < 12) type = 0; else if (pn < 18) type = 1; else if (pn < 20) type = 2; else if (pn == 20) type = (wc < 2) ? 3 : 1;
        else if (pn < 23) type = 4; else if (pn < 29) type = 5; else type = 6;
        if (type == 0) {
            const float sc = ((pn < 6) ? QS_A : 1.f) * one;
#pragma unroll
            for (int ai = 0; ai < 2; ++ai) {
                f32x4 c0[4], c1[4], s0[4], s1[4];
#pragma unroll
                for (int m = 0; m < 4; ++m) { const int t = (row0 + ai * HALF + m * 16) & (SEQ - 1); const float* cp = cosA + t * 32 + fq * 8; const float* sp = sinA + t * 32 + fq * 8;
                    c0[m] = *(const f32x4*)cp; c1[m] = *(const f32x4*)(cp + 4); s0[m] = *(const f32x4*)sp; s1[m] = *(const f32x4*)(sp + 4); }
#pragma unroll
                for (int m = 0; m < 4; ++m) { const int row = row0 + ai * HALF + m * 16;
                    const f32x4 xa0 = acc[ai][0][m][0], xa1 = acc[ai][0][m][1], xb0 = acc[ai][1][m][0], xb1 = acc[ai][1][m][1];
                    const f32x4 ya0 = (xa0 * c0[m] - xb0 * s0[m]) * sc, ya1 = (xa1 * c1[m] - xb1 * s1[m]) * sc, yb0 = (xa0 * s0[m] + xb0 * c0[m]) * sc, yb1 = (xa1 * s1[m] + xb1 * c1[m]) * sc;
                    bf16_t* rp = P + pidx(row, col); store_pair(rp, fr, pack8(ya0, ya1), pack8(yb0, yb1)); }
            }
        } else if (type == 2 || type == 3) {
            const float* nw = (type == 2) ? qn : kn; const float sc = ((type == 2) ? QS_A : 1.f) * one; const float sg = (fq < 2) ? -1.f : 1.f; const int ib = (fq & 1) * 8;
            const f32x4 w00 = *(const f32x4*)(nw + fq * 8), w01 = *(const f32x4*)(nw + fq * 8 + 4), w10 = *(const f32x4*)(nw + 32 + fq * 8), w11 = *(const f32x4*)(nw + 32 + fq * 8 + 4);
#pragma unroll
            for (int ai = 0; ai < 2; ++ai)
#pragma unroll
                for (int m = 0; m < 4; ++m) { const int row = row0 + ai * HALF + m * 16, t = row & (SEQ - 1);
                    f32x4 xa0 = acc[ai][0][m][0], xa1 = acc[ai][0][m][1], xb0 = acc[ai][1][m][0], xb1 = acc[ai][1][m][1];
                    const f32x4 q2 = xa0 * xa0 + xa1 * xa1 + xb0 * xb0 + xb1 * xb1; float ss = (q2[0] + q2[1]) + (q2[2] + q2[3]);
                    ss += __shfl_xor(ss, 16); ss += __shfl_xor(ss, 32);
                    const float rstd = rsqrtf(ss * (one * (1.f / 64.f)) + NORM_EPS);
                    xa0 = xa0 * rstd * w00; xa1 = xa1 * rstd * w01; xb0 = xb0 * rstd * w10; xb1 = xb1 * rstd * w11;
                    const int pr = (t >> 6) * 16 + ib, pc = (t & 63) * 16 + ib;
                    const f32x4 cr0 = *(const f32x4*)(cosB + pr), cr1 = *(const f32x4*)(cosB + pr + 4), sr0 = *(const f32x4*)(sinB + pr), sr1 = *(const f32x4*)(sinB + pr + 4);
                    const f32x4 cc0 = *(const f32x4*)(cosB + pc), cc1 = *(const f32x4*)(cosB + pc + 4), sc0 = *(const f32x4*)(sinB + pc), sc1 = *(const f32x4*)(sinB + pc + 4);
                    f32x4 pa0, pa1, pb0, pb1;
#pragma unroll
                    for (int e = 0; e < 4; ++e) { pa0[e] = __shfl_xor(xa0[e], 32); pa1[e] = __shfl_xor(xa1[e], 32); pb0[e] = __shfl_xor(xb0[e], 32); pb1[e] = __shfl_xor(xb1[e], 32); }
                    const f32x4 ya0 = (xa0 * cr0 + pa0 * sr0 * sg) * sc, ya1 = (xa1 * cr1 + pa1 * sr1 * sg) * sc, yb0 = (xb0 * cc0 + pb0 * sc0 * sg) * sc, yb1 = (xb1 * cc1 + pb1 * sc1 * sg) * sc;
                    bf16_t* rp = P + pidx(row, col); store8(rp, ya0, ya1); store8(rp + 32, yb0, yb1); }
        } else if (type == 5) {
#pragma unroll
            for (int ai = 0; ai < 2; ++ai)
#pragma unroll
                for (int m = 0; m < 4; ++m) { bf16_t* rp = P + pidx(row0 + ai * HALF + m * 16, col);
                    u32x4 wv[2];
#pragma unroll
                    for (int bj = 0; bj < 2; ++bj) { f32x4 v0 = acc[ai][bj][m][0], v1 = acc[ai][bj][m][1];
#pragma unroll
                        for (int e = 0; e < 4; ++e) { v0[e] = v0[e] * __builtin_amdgcn_rcpf(1.f + __builtin_amdgcn_exp2f(-LOG2E * v0[e])); v1[e] = v1[e] * __builtin_amdgcn_rcpf(1.f + __builtin_amdgcn_exp2f(-LOG2E * v1[e])); }
                        wv[bj] = pack8(v0, v1); }
                    store_pair(rp, fr, wv[0], wv[1]); }
        } else if (type == 6) {
            const float* bp = bmerge + (pn * BM - C_MG) + wc * 64 + fq * 8;
            f32x4 b[2][2];
#pragma unroll
            for (int bj = 0; bj < 2; ++bj) { b[bj][0] = *(const f32x4*)(bp + 32 * bj); b[bj][1] = *(const f32x4*)(bp + 32 * bj + 4); }
            unsigned char* gbase = (unsigned char*)(P + (size_t)pn * PTILE) + (size_t)wc * ((size_t)RC * 64) + fq * 16;
#pragma unroll
            for (int ai = 0; ai < 2; ++ai)
#pragma unroll
                for (int m = 0; m < 4; ++m) { u32x4 w;
#pragma unroll
                    for (int bj = 0; bj < 2; ++bj)
#pragma unroll
                        for (int n = 0; n < 2; ++n) { const f32x4 v = acc[ai][bj][m][n] + b[bj][n]; unsigned r = 0u;
#pragma unroll
                            for (int e = 0; e < 4; ++e) { const float g = __builtin_amdgcn_rcpf(1.f + __builtin_amdgcn_exp2f(-LOG2E * v[e])); r = __builtin_amdgcn_cvt_pk_u8_f32(__builtin_rintf(g * 255.f), e, r); }
                            w[2 * bj + n] = r; }
                    __builtin_nontemporal_store(w, (u32x4*)(gbase + (size_t)(row0 + ai * HALF + m * 16) * 64)); }
        } else {
            const float sc = ((type == 4) ? QS_M : 1.f) * one;
#pragma unroll
            for (int ai = 0; ai < 2; ++ai)
#pragma unroll
                for (int m = 0; m < 4; ++m) { bf16_t* rp = P + pidx(row0 + ai * HALF + m * 16, col);
                    store_pair(rp, fr, pack8(acc[ai][0][m][0] * sc, acc[ai][0][m][1] * sc), pack8(acc[ai][1][m][0] * sc, acc[ai][1][m][1] * sc)); }
        }
    }
};
struct EpiBr {
    const bf16_t* __restrict__ P; bf16_t* Y;
    __device__ __forceinline__ void operator()(const f32x4 (&acc)[2][2][4][2], const Unit& u, int wr, int wc, int fr, int fq) const {
        asm volatile("" : "+v"(fr), "+v"(fq));
        const int row0 = u.pm * BM + wr * 64 + fr, colw = wc * 64 + fq * 8, ycol = (u.pn & 3) * BM + colw; const bool first = (u.pn < 4);
        const unsigned char* gbytes = (const unsigned char*)(P + (size_t)((C_MG >> 8) + u.pn) * PTILE) + (size_t)wc * ((size_t)RC * 64) + fq * 16;
        u32x4 g[2][4];
#pragma unroll
        for (int ai = 0; ai < 2; ++ai)
#pragma unroll
            for (int m = 0; m < 4; ++m) { g[ai][m] = __builtin_nontemporal_load((const u32x4*)(gbytes + (size_t)(row0 + ai * HALF + m * 16) * 64)); }
#pragma unroll
        for (int ai = 0; ai < 2; ++ai) {
            u32x4 pv[4][2];
            if (!first) {
#pragma unroll
                for (int m = 0; m < 4; ++m) { const bf16_t* yp = Y + (size_t)(row0 + ai * HALF + m * 16) * 1024 + ycol; pv[m][0] = *(const u32x4*)yp; pv[m][1] = *(const u32x4*)(yp + 32); }
            } else {
#pragma unroll
                for (int m = 0; m < 4; ++m) { pv[m][0] = (u32x4){0u, 0u, 0u, 0u}; pv[m][1] = (u32x4){0u, 0u, 0u, 0u}; }
            }
#pragma unroll
            for (int m = 0; m < 4; ++m) { bf16_t* yp = Y + (size_t)(row0 + ai * HALF + m * 16) * 1024 + ycol;
                u32x4 wv[2];
#pragma unroll
                for (int bj = 0; bj < 2; ++bj) { const u32x2 gg = {g[ai][m][2 * bj], g[ai][m][2 * bj + 1]}; const u32x4 pp = pv[m][bj]; const f32x4 v0 = acc[ai][bj][m][0] * (1.f / 255.f), v1 = acc[ai][bj][m][1] * (1.f / 255.f);
#define GB(w_, k_) ((float)(((w_) >> (8 * (k_))) & 0xffu))
                    u32x4 w; w.x = pk2(bflo(pp.x) + v0[0] * GB(gg.x, 0), bfhi(pp.x) + v0[1] * GB(gg.x, 1)); w.y = pk2(bflo(pp.y) + v0[2] * GB(gg.x, 2), bfhi(pp.y) + v0[3] * GB(gg.x, 3));
                    w.z = pk2(bflo(pp.z) + v1[0] * GB(gg.y, 0), bfhi(pp.z) + v1[1] * GB(gg.y, 1)); w.w = pk2(bflo(pp.w) + v1[2] * GB(gg.y, 2), bfhi(pp.w) + v1[3] * GB(gg.y, 3));
#undef GB
                    wv[bj] = w; }
                store_pair<1024, false>(yp, fr, wv[0], wv[1]); }
        }
    }
};
struct EpiOut {
    float* outp; float* rowss;
    __device__ __forceinline__ void operator()(const f32x4 (&acc)[2][2][4][2], const Unit& u, int wr, int wc, int fr, int fq) const {
        asm volatile("" : "+v"(fr), "+v"(fq));
        const int row0 = u.pm * BM + wr * 64 + fr, col = u.pn * BM + wc * 64 + fq * 8;
#pragma unroll
        for (int ai = 0; ai < 2; ++ai)
#pragma unroll
            for (int m = 0; m < 4; ++m) { const int row = row0 + ai * HALF + m * 16; bf16_t* op = (bf16_t*)(outp + (size_t)row * 1024) + col; float ss = 0.f;
#pragma unroll
                for (int bj = 0; bj < 2; ++bj) { const f32x4 v0 = acc[ai][bj][m][0], v1 = acc[ai][bj][m][1];
                    const f32x4 q = v0 * v0 + v1 * v1; ss += (q[0] + q[1]) + (q[2] + q[3]); }
                store_pair<2048, true>(op, fr, pack8(acc[ai][0][m][0], acc[ai][0][m][1]), pack8(acc[ai][1][m][0], acc[ai][1][m][1]));
                ss += __shfl_xor(ss, 16); ss += __shfl_xor(ss, 32);
                if (fq == 0) atomicAdd(rowss + row, ss); }
    }
};
}

namespace attn_body {
using bf16=__hip_bfloat16;
using bf16x8=__attribute__((ext_vector_type(8)))short;
using s16x4=__attribute__((ext_vector_type(4)))short;
using f32x16=__attribute__((ext_vector_type(16)))float;
using u32x4=__attribute__((ext_vector_type(4)))unsigned;
constexpr int SEQ=4096,D=64,DM=256;
constexpr int CQ=4608,CK=5120,CV=5248,CG=6400,UP=512;
constexpr int NW=8,QBLK=32,QB=QBLK*NW,KVBLK=64;
__device__ __forceinline__ int crow(int r,int hi){return (r&3)+8*(r>>2)+4*hi;}
#define SBAR() __builtin_amdgcn_sched_barrier(0)
__device__ __forceinline__ void cmask(f32x16&p0,f32x16&p1,int jb,int qrel,int hi){
  const float NEG=-INFINITY; int kb=64*jb+4*hi;
  #pragma unroll
  for(int r=0;r<16;++r){int kv=kb+(r&3)+8*(r>>2); if(kv>qrel)p0[r]=NEG; if(kv+32>qrel)p1[r]=NEG;}
}

constexpr int NSLOT=3, SLOTB=8192;
constexpr int LDS_K=0, LDS_V=NSLOT*SLOTB, LDS_WS=2*NSLOT*SLOTB, LDS_OST=LDS_WS+NW*64*4, LDS_BYTES=LDS_OST+NW*4096;
constexpr float C2=0.125f*1.4426950408889634f;
__device__ __forceinline__ void glds16(const void*gsrc,unsigned lds_dst){unsigned keep;
  asm volatile("s_mov_b32 %0, m0\n\ts_mov_b32 m0, %2\n\ts_nop 0\n\tglobal_load_lds_dwordx4 %1, off\n\ts_mov_b32 m0, %0":"=&s"(keep):"v"(gsrc),"s"(lds_dst):"memory");}
__device__ __forceinline__ float max3f(float a,float b,float c){float r;asm("v_max3_f32 %0, %1, %2, %3":"=v"(r):"v"(a),"v"(b),"v"(c));return r;}
__device__ __forceinline__ float max2f(float a,float b){float r;asm("v_max_f32_e32 %0, %1, %2":"=v"(r):"v"(a),"v"(b));return r;}
__device__ __forceinline__ float fadd_s(float a,float b){float r;asm("v_add_f32_e32 %0, %1, %2":"=v"(r):"v"(a),"v"(b));return r;}
__device__ __forceinline__ float fsub_s(float a,float b){float r;asm("v_sub_f32_e32 %0, %1, %2":"=v"(r):"v"(a),"v"(b));return r;}
typedef float f32x2_t __attribute__((ext_vector_type(2))); typedef __bf16 bf16x2_t __attribute__((ext_vector_type(2)));
__device__ __forceinline__ unsigned cvtpk_s(float lo,float hi){f32x2_t v={lo,hi};bf16x2_t b=__builtin_convertvector(v,bf16x2_t);return __builtin_bit_cast(unsigned,b);}
#define WAIT_BAR(N) asm volatile("s_waitcnt vmcnt(" #N ") lgkmcnt(0)\n\ts_barrier":::"memory")

__device__ __forceinline__ void qkt(f32x16&p0,f32x16&p1,const char*Kslot,const bf16x8*qr,const f32x16&negm,int r32,int hi){
  const char*kb=Kslot+hi*1024+r32*16;
  #pragma unroll
  for(int d0=0;d0<4;++d0){
    const bf16x8 b0=*reinterpret_cast<const bf16x8*>(kb+d0*2048);
    const bf16x8 b1=*reinterpret_cast<const bf16x8*>(kb+d0*2048+512);
    if(d0==0){p0=__builtin_amdgcn_mfma_f32_32x32x16_bf16(b0,qr[0],negm,0,0,0);p1=__builtin_amdgcn_mfma_f32_32x32x16_bf16(b1,qr[0],negm,0,0,0);}
    else{p0=__builtin_amdgcn_mfma_f32_32x32x16_bf16(b0,qr[d0],p0,0,0,0);p1=__builtin_amdgcn_mfma_f32_32x32x16_bf16(b1,qr[d0],p1,0,0,0);}}
}
typedef __attribute__((address_space(3))) const char* lds_cptr;
typedef short v4i16_t __attribute__((ext_vector_type(4)));
__device__ __forceinline__ void kload8(bf16x8*kf,lds_cptr kp){
  kf[0]=*(const __attribute__((address_space(3))) bf16x8*)(kp);      kf[1]=*(const __attribute__((address_space(3))) bf16x8*)(kp+512);
  kf[2]=*(const __attribute__((address_space(3))) bf16x8*)(kp+2048); kf[3]=*(const __attribute__((address_space(3))) bf16x8*)(kp+2560);
  kf[4]=*(const __attribute__((address_space(3))) bf16x8*)(kp+4096); kf[5]=*(const __attribute__((address_space(3))) bf16x8*)(kp+4608);
  kf[6]=*(const __attribute__((address_space(3))) bf16x8*)(kp+6144); kf[7]=*(const __attribute__((address_space(3))) bf16x8*)(kp+6656);
}
__device__ __forceinline__ void kload2(bf16x8*kf,lds_cptr kp,int j){ kf[2*j]=*(const __attribute__((address_space(3))) bf16x8*)(kp+j*2048); kf[2*j+1]=*(const __attribute__((address_space(3))) bf16x8*)(kp+j*2048+512); }
__device__ __forceinline__ s16x4 vtr(lds_cptr p){ return __builtin_bit_cast(s16x4,__builtin_amdgcn_ds_read_tr16_b64_v4i16((__attribute__((address_space(3))) v4i16_t*)p)); }
__device__ __forceinline__ float rowmax(const f32x16&p0,const f32x16&p1){
  float a=max3f(p0[0],p0[1],p1[0]),b=max3f(p0[2],p0[3],p1[1]);a=max3f(a,p1[2],p1[3]);
  #pragma unroll
  for(int r=4;r<16;r+=4){a=max3f(a,p0[r],p0[r+1]);b=max3f(b,p0[r+2],p0[r+3]);a=max3f(a,p1[r],p1[r+1]);b=max3f(b,p1[r+2],p1[r+3]);}
  const float m=max2f(a,b);
  auto rr=__builtin_amdgcn_permlane32_swap(__float_as_uint(m),__float_as_uint(m),false,false);
  return max2f(__uint_as_float(rr[0]),__uint_as_float(rr[1]));
}
__device__ __forceinline__ void pv(f32x16*o,int vb,bf16x8 pa0,bf16x8 pa1,bf16x8 pa2,bf16x8 pa3){
  #pragma unroll
  for(int d0=0;d0<2;++d0){s16x4 lo[4],hi[4];
    #pragma unroll
    for(int ks=0;ks<4;++ks){
      asm volatile("ds_read_b64_tr_b16 %0,%1 offset:%c2":"=&v"(lo[ks]):"v"(vb),"i"(d0*4096+ks*1024):"memory");
      asm volatile("ds_read_b64_tr_b16 %0,%1 offset:%c2":"=&v"(hi[ks]):"v"(vb),"i"(d0*4096+ks*1024+512):"memory");}
    asm volatile("s_waitcnt lgkmcnt(0)":::"memory");SBAR();
    #define PK(k) (bf16x8){lo[k][0],lo[k][1],lo[k][2],lo[k][3],hi[k][0],hi[k][1],hi[k][2],hi[k][3]}
    o[d0]=__builtin_amdgcn_mfma_f32_32x32x16_bf16(pa0,PK(0),o[d0],0,0,0);
    o[d0]=__builtin_amdgcn_mfma_f32_32x32x16_bf16(pa1,PK(1),o[d0],0,0,0);
    o[d0]=__builtin_amdgcn_mfma_f32_32x32x16_bf16(pa2,PK(2),o[d0],0,0,0);
    o[d0]=__builtin_amdgcn_mfma_f32_32x32x16_bf16(pa3,PK(3),o[d0],0,0,0);
    #undef PK
  }
}

#ifndef ATTN_STORE16
#define ATTN_STORE16(p,v) (*(u32x4*)(p)=(v))
#endif
template<int THRL> __device__ __forceinline__ void attn_unit(long rowbase,int h,int qb,const bf16*__restrict__ Pm,bf16*Ub,char*shm){
  int tid_=threadIdx.x; asm volatile("":"+v"(tid_)); const int tid=tid_,lane=tid&63,r32=lane&31,hi=lane>>5; const int wid=__builtin_amdgcn_readfirstlane(tid>>6);
  const int q0=qb*QB;
  const bf16*Qw=Pm+pidx(rowbase+q0+wid*QBLK,CQ+h*D);
  const bf16*Kh=Pm+pidx(rowbase,CK+(h>>2)*D),*Vh=Pm+pidx(rowbase,CV+(h>>2)*D);
  const unsigned lds0=(unsigned)(uintptr_t)shm;
  float*wsf=(float*)(shm+LDS_WS)+wid*64;
  const bf16*ksrc=Kh+(long)lane*DM+wid*8;
  const bf16*vsrc=Vh+(long)(16*(wid&3)+(lane>>2))*DM+(wid>>2)*32+(lane&3)*8;
  const unsigned kdst=lds0+LDS_K+wid*1024, vdst=lds0+LDS_V+wid*1024;
  #define DMA_K(t,slot) glds16(ksrc+(long)(t)*KVBLK*DM,(unsigned)__builtin_amdgcn_readfirstlane(kdst+(slot)))
  #define DMA_V(t,slot) glds16(vsrc+(long)(t)*KVBLK*DM,(unsigned)__builtin_amdgcn_readfirstlane(vdst+(slot)))
  const int vb0=(int)(lds0+LDS_V)+((lane>>4)&1)*32+(lane&3)*8+(4*hi+((lane&15)>>2))*64;
  const char*Kbase=shm+LDS_K; bf16x8 kf[8];
  const lds_cptr shm3=(lds_cptr)shm; const lds_cptr kp0=shm3+LDS_K+hi*1024+r32*16; const lds_cptr vp0=shm3+LDS_V+((lane>>4)&1)*32+(lane&3)*8+(4*hi+((lane&15)>>2))*64;
  const int NT=SEQ/KVBLK;
  DMA_K(0,0);DMA_V(0,0);DMA_K(1,SLOTB);
  bf16x8 qr[4];
  #pragma unroll
  for(int d0=0;d0<4;++d0)qr[d0]=*reinterpret_cast<const bf16x8*>(&Qw[(long)r32*DM+d0*16+hi*8]);
  float mhat=0.f,l_reg=0.f;f32x16 o[2];o[0]=f32x16{};o[1]=f32x16{};f32x16 negm=f32x16{};asm volatile("":"+v"(negm));
  const int qrel=wid*QBLK+r32;
  #define CMASK(P0,P1,t) do{}while(0)
  bool resc=false;
  #define START(P0,P1) do{ const float rm=rowmax(P0,P1); resc=false; \
    { const float dl=rm; mhat=fadd_s(mhat,dl); \
      _Pragma("unroll") for(int r=0;r<16;++r){P0[r]=fsub_s(P0[r],dl);P1[r]=fsub_s(P1[r],dl);} \
      _Pragma("unroll") for(int r=0;r<16;++r)negm[r]=-mhat; asm volatile("":"+v"(negm)); } \
    _Pragma("unroll") for(int r=0;r<16;++r)P0[r]=__builtin_amdgcn_exp2f(P0[r]); }while(0)
  #define RESC() do{ if(resc){ asm volatile("s_waitcnt lgkmcnt(0)":::"memory"); \
      _Pragma("unroll") for(int d_=0;d_<2;++d_) _Pragma("unroll") for(int r=0;r<16;++r)o[d_][r]*=wsf[crow(r,hi)]; } }while(0)
  f32x16 pA0,pA1,pB0,pB1;
  int sl_prev=0,sl_cur=0,sl_next=SLOTB;
  #define ROT() do{sl_prev=sl_cur;sl_cur=sl_next;sl_next=(sl_next==(NSLOT-1)*SLOTB)?0:sl_next+SLOTB;}while(0)
  DMA_K(2,2*SLOTB);
  WAIT_BAR(3);
  qkt(pA0,pA1,Kbase,qr,negm,r32,hi);asm volatile("s_nop 15\n\ts_nop 7":"+v"(pA0),"+v"(pA1));CMASK(pA0,pA1,0);
  START(pA0,pA1);
  _Pragma("unroll") for(int r=0;r<16;++r)pA1[r]=__builtin_amdgcn_exp2f(pA1[r]);
  WAIT_BAR(0);
  DMA_K(3,0);DMA_V(1,SLOTB);
  ROT();
  kload8(kf,kp0+sl_cur);
  WAIT_BAR(2);
  s16x4 vlo[8],vhi[8]; u32x4 pw0,pw1,pw2,pw3;
  #define PKW(P,B) cvtpk_s(P[B],P[B+1])
  #define PAF(k) __builtin_bit_cast(bf16x8,pw##k)
  #define VFR(i) (bf16x8){vlo[i][0],vlo[i][1],vlo[i][2],vlo[i][3],vhi[i][0],vhi[i][1],vhi[i][2],vhi[i][3]}
  #define PIN(x) asm volatile("":"+v"(x))
  #define MX3(a,b,c) __builtin_fmaxf(__builtin_fmaxf((a),(b)),(c))
  #define GAPA(MF,A0,A1,A2,A3,W0,W1,PW) do{ MF; sacc+=A0; sacc+=A1; sacc+=A2; sacc+=A3; PIN(sacc); W0; W1; PIN(PW); SBAR(); }while(0)
  #define EX(v) __builtin_amdgcn_exp2f(v)
  #define GAPB(MF,X,B) do{ MF; X[B]=EX(X[B]); X[B+1]=EX(X[B+1]); X[B+2]=EX(X[B+2]); X[B+3]=EX(X[B+3]); PIN(X); SBAR(); }while(0)
  #define VRD(i) do{ vlo[i]=vtr(vp_+(((i)>>2)*4096+((i)&3)*1024)); vhi[i]=vtr(vp_+(((i)>>2)*4096+((i)&3)*1024+512)); }while(0)
  #define KRD(G,j) do{ if(G){ kload2(kf,kp0+sl_next,j); SBAR(); } }while(0)
  #define STEP(C0,C1,P0,P1,t,GK,GV,GL) do{ SBAR(); \
    const lds_cptr vp_=vp0+sl_prev; \
    VRD(0); SBAR(); float sacc=(P0[0]+P0[1]); \
    GAPA(C0=__builtin_amdgcn_mfma_f32_32x32x16_bf16(kf[0],qr[0],negm,0,0,0), P0[2],P0[3],P0[4],P0[5],     pw0[0]=PKW(P0,0), pw0[1]=PKW(P0,2), pw0); \
    VRD(4); SBAR(); GAPA(C1=__builtin_amdgcn_mfma_f32_32x32x16_bf16(kf[1],qr[0],negm,0,0,0), P0[6],P0[7],P0[8],P0[9],     pw0[2]=PKW(P0,4), pw0[3]=PKW(P0,6), pw0); \
    VRD(1); SBAR(); GAPA(C0=__builtin_amdgcn_mfma_f32_32x32x16_bf16(kf[2],qr[1],C0,0,0,0),   P0[10],P0[11],P0[12],P0[13], pw1[0]=PKW(P0,8), pw1[1]=PKW(P0,10), pw1); \
    VRD(5); SBAR(); GAPA(C1=__builtin_amdgcn_mfma_f32_32x32x16_bf16(kf[3],qr[1],C1,0,0,0),   P0[14],P0[15],P1[0],P1[1],   pw1[2]=PKW(P0,12),pw1[3]=PKW(P0,14), pw1); \
    VRD(2); SBAR(); GAPA(C0=__builtin_amdgcn_mfma_f32_32x32x16_bf16(kf[4],qr[2],C0,0,0,0),   P1[2],P1[3],P1[4],P1[5],     pw2[0]=PKW(P1,0), pw2[1]=PKW(P1,2), pw2); \
    VRD(6); SBAR(); GAPA(C1=__builtin_amdgcn_mfma_f32_32x32x16_bf16(kf[5],qr[2],C1,0,0,0),   P1[6],P1[7],P1[8],P1[9],     pw2[2]=PKW(P1,4), pw2[3]=PKW(P1,6), pw2); \
    VRD(3); SBAR(); GAPA(C0=__builtin_amdgcn_mfma_f32_32x32x16_bf16(kf[6],qr[3],C0,0,0,0),   P1[10],P1[11],P1[12],P1[13], pw3[0]=PKW(P1,8), pw3[1]=PKW(P1,10), pw3); \
    VRD(7); SBAR(); GAPA(C1=__builtin_amdgcn_mfma_f32_32x32x16_bf16(kf[7],qr[3],C1,0,0,0),   P1[14],P1[15],0.f,0.f,       pw3[2]=PKW(P1,12),pw3[3]=PKW(P1,14), pw3); \
    l_reg+=sacc; \
    if(GK){DMA_K((t)+3,sl_cur);} if(GV){DMA_V((t)+1,sl_next);} \
    CMASK(C0,C1,t); \
    { float a=MX3(C0[0],C0[1],C1[0]),b=MX3(C0[2],C0[3],C1[1]); a=MX3(a,C1[2],C1[3]); \
      _Pragma("unroll") for(int r=4;r<16;r+=4){a=MX3(a,C0[r],C0[r+1]);b=MX3(b,C0[r+2],C0[r+3]);a=MX3(a,C1[r],C1[r+1]);b=MX3(b,C1[r+2],C1[r+3]);} \
      float rm=__builtin_fmaxf(a,b); { auto rr=__builtin_amdgcn_permlane32_swap(__float_as_uint(rm),__float_as_uint(rm),false,false); rm=__builtin_fmaxf(__uint_as_float(rr[0]),__uint_as_float(rr[1])); } \
      resc=false; \
      if(__builtin_expect(__any(rm>(float)THRL),0)){ const float dl=__builtin_fmaxf(rm,0.f); mhat+=dl; \
        _Pragma("unroll") for(int r=0;r<16;++r){C0[r]-=dl;C1[r]-=dl;} \
        _Pragma("unroll") for(int r=0;r<16;++r)negm[r]=-mhat; asm volatile("":"+v"(negm)); \
        const float f=__builtin_amdgcn_exp2f(-dl); l_reg*=f; if(hi==0)wsf[r32]=f; resc=true; } } \
    SBAR(); \
    GAPB(o[0]=__builtin_amdgcn_mfma_f32_32x32x16_bf16(PAF(0),VFR(0),o[0],0,0,0), C0,0); \
    GAPB(o[1]=__builtin_amdgcn_mfma_f32_32x32x16_bf16(PAF(0),VFR(4),o[1],0,0,0), C0,4); \
    KRD(GL,0); GAPB(o[0]=__builtin_amdgcn_mfma_f32_32x32x16_bf16(PAF(1),VFR(1),o[0],0,0,0), C0,8); \
    KRD(GL,1); GAPB(o[1]=__builtin_amdgcn_mfma_f32_32x32x16_bf16(PAF(1),VFR(5),o[1],0,0,0), C0,12); \
    KRD(GL,2); GAPB(o[0]=__builtin_amdgcn_mfma_f32_32x32x16_bf16(PAF(2),VFR(2),o[0],0,0,0), C1,0); \
    KRD(GL,3); GAPB(o[1]=__builtin_amdgcn_mfma_f32_32x32x16_bf16(PAF(2),VFR(6),o[1],0,0,0), C1,4); \
    GAPB(o[0]=__builtin_amdgcn_mfma_f32_32x32x16_bf16(PAF(3),VFR(3),o[0],0,0,0), C1,8); \
    GAPB(o[1]=__builtin_amdgcn_mfma_f32_32x32x16_bf16(PAF(3),VFR(7),o[1],0,0,0), C1,12); \
    }while(0)
  int t=1;
  #undef CMASK
  #define CMASK(P0,P1,t) do{}while(0)
  for(;t+5<NT;t+=2){
    STEP(pB0,pB1,pA0,pA1,t,true,true,true);     WAIT_BAR(2); RESC(); ROT();
    STEP(pA0,pA1,pB0,pB1,t+1,true,true,true);   WAIT_BAR(2); RESC(); ROT();
  }
  #undef CMASK
  #define CMASK(P0,P1,t) do{}while(0)
  #define ENDW(tt) do{ if((tt)+3<NT){WAIT_BAR(2);} else if((tt)+2<NT){WAIT_BAR(1);} else {WAIT_BAR(0);} }while(0)
  for(;t+1<NT;t+=2){
    STEP(pB0,pB1,pA0,pA1,t,(t+3<NT),(t+1<NT),(t+1<NT));       ENDW(t);   RESC(); ROT();
    STEP(pA0,pA1,pB0,pB1,t+1,(t+4<NT),(t+2<NT),(t+2<NT));     ENDW(t+1); RESC(); ROT();
  }
  STEP(pB0,pB1,pA0,pA1,NT-1,false,false,false); RESC();
  { float sacc=pB0[0]+pB0[1]; _Pragma("unroll") for(int r=2;r<16;++r)sacc+=pB0[r]; _Pragma("unroll") for(int r=0;r<16;++r)sacc+=pB1[r]; l_reg+=sacc;
    pw0=(u32x4){PKW(pB0,0),PKW(pB0,2),PKW(pB0,4),PKW(pB0,6)};pw1=(u32x4){PKW(pB0,8),PKW(pB0,10),PKW(pB0,12),PKW(pB0,14)};pw2=(u32x4){PKW(pB1,0),PKW(pB1,2),PKW(pB1,4),PKW(pB1,6)};pw3=(u32x4){PKW(pB1,8),PKW(pB1,10),PKW(pB1,12),PKW(pB1,14)};
    SBAR(); pv(o,vb0+sl_cur,PAF(0),PAF(1),PAF(2),PAF(3)); }
  #undef PKW
  #undef PAF
  #undef VFR
  #undef PIN
  #undef MX3
  #undef GAPA
  #undef GAPB
  #undef EX
  #undef VRD
  #undef KRD
  #undef STEP
  #undef ENDW
  {auto rr=__builtin_amdgcn_permlane32_swap(__float_as_uint(l_reg),__float_as_uint(l_reg),false,false);l_reg=__uint_as_float(rr[0])+__uint_as_float(rr[1]);}
  if(hi==0)wsf[32+r32]=l_reg;asm volatile("s_waitcnt lgkmcnt(0)":::"memory");
  float rli[16];
  #pragma unroll
  for(int r=0;r<16;++r)rli[r]=__builtin_amdgcn_rcpf(wsf[32+crow(r,hi)]);
  bf16*Ow=Ub+(rowbase+q0+wid*QBLK)*UP+h*D; const bf16*Gw=Pm+pidx(rowbase+q0+wid*QBLK,CG+h*D);
  { bf16*stg=(bf16*)(shm+LDS_OST)+wid*2048;
    #pragma unroll
    for(int r=0;r<16;++r){const int orow=crow(r,hi);
      #pragma unroll
      for(int d0=0;d0<2;++d0)stg[orow*64+d0*32+r32]=__float2bfloat16(o[d0][r]*rli[r]);}
    asm volatile("s_waitcnt lgkmcnt(0)":::"memory");
    #pragma unroll
    for(int i=0;i<4;++i){const int row=i*8+(lane>>3),ch=lane&7; const u32x4 v=*(const u32x4*)(stg+row*64+ch*8); const u32x4 gt=*(const u32x4*)(Gw+(long)row*DM+ch*8); u32x4 w;
      _Pragma("unroll") for(int e=0;e<4;++e){const float lo=__uint_as_float(v[e]<<16)*__uint_as_float(gt[e]<<16),hh=__uint_as_float(v[e]&0xffff0000u)*__uint_as_float(gt[e]&0xffff0000u); w[e]=cvtpk_s(lo,hh);}
      ATTN_STORE16(Ow+(long)row*UP+ch*8,w);} }
  asm volatile("s_waitcnt lgkmcnt(0)\n\ts_barrier":::"memory");
  #undef DMA_K
  #undef DMA_V
  #undef CMASK
  #undef START
  #undef RESC
  #undef ROT
}
constexpr int ATTN_LDS_BYTES=LDS_BYTES;
#undef SBAR
#undef WAIT_BAR
}

namespace wa {
typedef short v4i16_t __attribute__((ext_vector_type(4)));
__device__ __forceinline__ int crow(int r, int hi) { return (r & 3) + 8 * (r >> 2) + 4 * hi; }
__device__ __forceinline__ s16x4 vtr(const LAS char* p) { return __builtin_bit_cast(s16x4, __builtin_amdgcn_ds_read_tr16_b64_v4i16((LAS v4i16_t*)p)); }

template <int DH> struct State { float m, l; f32x16 o[DH / 32]; };

template <int DH, bool MASK>
__device__ __forceinline__ void tile(State<DH>& st, const bf16x8 (&qf)[DH / 16], const LAS char* kl, const LAS char* vl, int lane, int dq) {
    constexpr int NS = DH / 16, ND = DH / 32, ROWB = DH * 2 + 16;
    const int r = lane & 31, h = lane >> 5;
    const LAS char* kp = kl + r * ROWB + 16 * h;
    f32x16 S = {};
#pragma unroll
    for (int s = 0; s < NS; ++s) S = __builtin_amdgcn_mfma_f32_32x32x16_bf16(*(const LAS bf16x8*)(kp + 32 * s), qf[s], S, 0, 0, 0);
    if (MASK) {
#pragma unroll
        for (int i = 0; i < 16; ++i) { const int d = dq - crow(i, h); if (d > 64 || d < -64) S[i] = -1e30f; }
    }
    float tmax = S[0];
#pragma unroll
    for (int i = 1; i < 16; ++i) tmax = fmaxf(tmax, S[i]);
    tmax = fmaxf(tmax, __shfl_xor(tmax, 32));
    const float mnew = fmaxf(st.m, tmax), alpha = __builtin_amdgcn_exp2f(st.m - mnew);
    st.m = mnew;
    float psum = 0.f;
#pragma unroll
    for (int i = 0; i < 16; ++i) { S[i] = __builtin_amdgcn_exp2f(S[i] - mnew); psum += S[i]; }
    st.l = st.l * alpha + psum;
#pragma unroll
    for (int d = 0; d < ND; ++d)
#pragma unroll
        for (int i = 0; i < 16; ++i) st.o[d][i] *= alpha;
    u32x4 p0, p1;
    p0.x = pk2(S[0], S[1]); p0.y = pk2(S[2], S[3]); p0.z = pk2(S[4], S[5]); p0.w = pk2(S[6], S[7]);
    p1.x = pk2(S[8], S[9]); p1.y = pk2(S[10], S[11]); p1.z = pk2(S[12], S[13]); p1.w = pk2(S[14], S[15]);
    const bf16x8 pf0 = __builtin_bit_cast(bf16x8, p0), pf1 = __builtin_bit_cast(bf16x8, p1);
    const int i16 = lane & 15, q4 = i16 >> 2, p4 = i16 & 3, blk = (lane >> 4) & 1;
    const LAS char* vb = vl + (4 * h + q4) * ROWB + 32 * blk + 8 * p4;
#pragma unroll
    for (int d = 0; d < ND; ++d) {
        const s16x4 lo0 = vtr(vb + d * 64), hi0 = vtr(vb + d * 64 + 8 * ROWB), lo1 = vtr(vb + d * 64 + 16 * ROWB), hi1 = vtr(vb + d * 64 + 24 * ROWB);
        const bf16x8 v0 = __builtin_shufflevector(lo0, hi0, 0, 1, 2, 3, 4, 5, 6, 7), v1 = __builtin_shufflevector(lo1, hi1, 0, 1, 2, 3, 4, 5, 6, 7);
        st.o[d] = __builtin_amdgcn_mfma_f32_32x32x16_bf16(v0, pf0, st.o[d], 0, 0, 0);
        st.o[d] = __builtin_amdgcn_mfma_f32_32x32x16_bf16(v1, pf1, st.o[d], 0, 0, 0);
    }
}

constexpr int A_ROWB = 144, A_KROWS = 384, A_VOFF = A_KROWS * A_ROWB, A_NU = BPC * 8 * 3 * 16;
struct AUnit { int b, hh, g, dil, res, sp; };
__device__ __forceinline__ AUnit a_decode(int uid) { AUnit u; const int rs = uid & 15; u.g = (uid >> 4) % 3; u.hh = (uid / 48) & 7; u.b = uid / 384; u.dil = (u.g == 0) ? 1 : (u.g == 1) ? 4 : 16; const int spr = 16 / u.dil; u.res = rs / spr; u.sp = rs % spr; return u; }
__device__ __forceinline__ void a_load(const bf16_t* __restrict__ P, int uid, int tid, int wave, int lane, u32x4 (&kr)[6], u32x4 (&vr)[6], bf16x8 (&qn)[4]) {
    const AUnit u = a_decode(uid); const int L = SEQ / u.dil, qcol = (u.g * 8 + u.hh) * 64;
    const size_t rb = (size_t)u.b * SEQ;
#pragma unroll
    for (int it = 0; it < 6; ++it) { const int idx = tid + 512 * it, row = idx >> 3, ch = idx & 7, m = 256 * u.sp - 64 + row;
        if (m >= 0 && m < L) { const size_t rw = rb + (size_t)(m * u.dil + u.res); kr[it] = *(const u32x4*)(P + pidx(rw, C_AK + qcol + ch * 8)); vr[it] = *(const u32x4*)(P + pidx(rw, C_AV + qcol + ch * 8)); } }
    { const int r = lane & 31, h = lane >> 5, mq = 256 * u.sp + 32 * wave + r; const bf16_t* qp = P + pidx(rb + (size_t)(mq * u.dil + u.res), C_AQ + qcol + 8 * h);
#pragma unroll
      for (int s = 0; s < 4; ++s) qn[s] = *(const bf16x8*)(qp + 16 * s); }
}
__device__ __forceinline__ void mixA_phase(const bf16_t* __restrict__ P, bf16_t* OA, float* LSE, LAS char* lds, int tid, int vcu, int G) {
    const int lane = tid & 63, wave = __builtin_amdgcn_readfirstlane(tid >> 6), r = lane & 31, h = lane >> 5;
    u32x4 kr[6], vr[6]; bf16x8 qn[4];
    int uid = vcu;
    if (uid < A_NU) a_load(P, uid, tid, wave, lane, kr, vr, qn);
    for (; uid < A_NU; uid += G) {
#pragma unroll
        for (int it = 0; it < 6; ++it) { const int idx = tid + 512 * it, row = idx >> 3, ch = idx & 7; *(LAS u32x4*)(lds + row * A_ROWB + ch * 16) = kr[it]; *(LAS u32x4*)(lds + A_VOFF + row * A_ROWB + ch * 16) = vr[it]; }
        bf16x8 qf[4];
#pragma unroll
        for (int s = 0; s < 4; ++s) qf[s] = qn[s];
        __syncthreads();
        if (uid + G < A_NU) a_load(P, uid + G, tid, wave, lane, kr, vr, qn);
        const AUnit u = a_decode(uid); const int L = SEQ / u.dil, m0 = 256 * u.sp + 32 * wave;
        State<64> st; st.o[0] = f32x16{}; st.o[1] = f32x16{};
        f32x16 S[5]; bool ok[5]; float mx = -1e30f;
        const LAS char* kp = lds + (32 * wave + r) * A_ROWB + 16 * h;
#pragma unroll
        for (int j = 0; j < 5; ++j) {
            const int mk0 = m0 - 64 + 32 * j; ok[j] = (mk0 >= 0 && mk0 < L);
            if (ok[j]) {
                f32x16 s_ = {};
#pragma unroll
                for (int s = 0; s < 4; ++s) s_ = __builtin_amdgcn_mfma_f32_32x32x16_bf16(*(const LAS bf16x8*)(kp + 32 * j * A_ROWB + 32 * s), qf[s], s_, 0, 0, 0);
                if (j == 0 || j == 4) {
                    const int dq = r + 64 - 32 * j;
#pragma unroll
                    for (int i = 0; i < 16; ++i) { const int d = dq - crow(i, h); if (d > 64 || d < -64) s_[i] = -1e30f; }
                }
#pragma unroll
                for (int i = 0; i < 16; ++i) mx = fmaxf(mx, s_[i]);
                S[j] = s_;
            }
        }
        mx = fmaxf(mx, __shfl_xor(mx, 32));
        float psum = 0.f;
        const int i16 = lane & 15, q4 = i16 >> 2, p4 = i16 & 3, blk = (lane >> 4) & 1;
        const LAS char* vb = lds + A_VOFF + (32 * wave + 4 * h + q4) * A_ROWB + 32 * blk + 8 * p4;
#pragma unroll
        for (int j = 0; j < 5; ++j) {
            if (ok[j]) {
                f32x16 s_ = S[j];
#pragma unroll
                for (int i = 0; i < 16; ++i) { s_[i] = __builtin_amdgcn_exp2f(s_[i] - mx); psum += s_[i]; }
                u32x4 p0, p1;
                p0.x = pk2(s_[0], s_[1]); p0.y = pk2(s_[2], s_[3]); p0.z = pk2(s_[4], s_[5]); p0.w = pk2(s_[6], s_[7]);
                p1.x = pk2(s_[8], s_[9]); p1.y = pk2(s_[10], s_[11]); p1.z = pk2(s_[12], s_[13]); p1.w = pk2(s_[14], s_[15]);
                const bf16x8 pf0 = __builtin_bit_cast(bf16x8, p0), pf1 = __builtin_bit_cast(bf16x8, p1);
                const LAS char* vj = vb + 32 * j * A_ROWB;
#pragma unroll
                for (int d = 0; d < 2; ++d) {
                    const s16x4 lo0 = vtr(vj + d * 64), hi0 = vtr(vj + d * 64 + 8 * A_ROWB), lo1 = vtr(vj + d * 64 + 16 * A_ROWB), hi1 = vtr(vj + d * 64 + 24 * A_ROWB);
                    const bf16x8 v0 = __builtin_shufflevector(lo0, hi0, 0, 1, 2, 3, 4, 5, 6, 7), v1 = __builtin_shufflevector(lo1, hi1, 0, 1, 2, 3, 4, 5, 6, 7);
                    st.o[d] = __builtin_amdgcn_mfma_f32_32x32x16_bf16(v0, pf0, st.o[d], 0, 0, 0);
                    st.o[d] = __builtin_amdgcn_mfma_f32_32x32x16_bf16(v1, pf1, st.o[d], 0, 0, 0);
                }
            }
        }
        st.m = mx; st.l = psum;
        const float lt = st.l + __shfl_xor(st.l, 32), inv = 1.f / lt;
        const size_t orow = (size_t)u.b * SEQ + (size_t)((m0 + r) * u.dil + u.res);
        LAS char* sg = lds + 2 * A_VOFF + wave * 4096;
#pragma unroll
        for (int d = 0; d < 2; ++d)
#pragma unroll
            for (int i4 = 0; i4 < 4; ++i4) { u32x2 w; w.x = pk2(st.o[d][4 * i4] * inv, st.o[d][4 * i4 + 1] * inv); w.y = pk2(st.o[d][4 * i4 + 2] * inv, st.o[d][4 * i4 + 3] * inv);
                *(LAS u32x2*)(sg + r * 128 + (((4 * d + i4) ^ (r & 7)) << 4) + 8 * h) = w; }
        if (h == 0) LSE[orow * 24 + u.g * 8 + u.hh] = st.m + __builtin_amdgcn_logf(lt);
        asm volatile("s_waitcnt lgkmcnt(0)" ::: "memory");
#pragma unroll
        for (int i = 0; i < 4; ++i) { const int row = i * 8 + (lane >> 3), ch = lane & 7;
            const u32x4 v = *(const LAS u32x4*)(sg + row * 128 + ((ch ^ (row & 7)) << 4));
            *(u32x4*)(OA + ((size_t)u.b * SEQ + (size_t)((m0 + row) * u.dil + u.res)) * 1536 + u.g * 512 + u.hh * 64 + ch * 8) = v; }
        __syncthreads();
    }
}

constexpr int M_ROWB = 272, M_VOFF = 256 * M_ROWB, M_NU = BPC * 4 * 8;
__device__ __forceinline__ void m_tile(const bf16_t* __restrict__ P, bf16_t* UM, long qrow, int hh, const bf16x8 (&qf)[8], LAS char* lds, int lane) {
    const int h = lane >> 5;
    const bf16_t* gp = P + pidx(qrow, C_GM + hh * 128 + 4 * h);
    u32x2 g[4][4];
#pragma unroll
    for (int d = 0; d < 4; ++d)
#pragma unroll
        for (int i4 = 0; i4 < 4; ++i4) g[d][i4] = *(const u32x2*)(gp + 32 * d + 8 * i4);
    State<128> st; st.m = -1e30f; st.l = 0.f;
#pragma unroll
    for (int d = 0; d < 4; ++d) st.o[d] = f32x16{};
    for (int j = 0; j < 8; ++j) tile<128, false>(st, qf, lds + 32 * j * M_ROWB, lds + M_VOFF + 32 * j * M_ROWB, lane, 0);
    const float lt = st.l + __shfl_xor(st.l, 32), inv = 1.f / lt;
    bf16_t* op = UM + (size_t)qrow * 512 + hh * 128 + 4 * h;
#pragma unroll
    for (int d = 0; d < 4; ++d)
#pragma unroll
        for (int i4 = 0; i4 < 4; ++i4) { const u32x2 gg = g[d][i4]; u32x2 w;
            w.x = pk2(st.o[d][4 * i4] * inv * bflo(gg.x), st.o[d][4 * i4 + 1] * inv * bfhi(gg.x)); w.y = pk2(st.o[d][4 * i4 + 2] * inv * bflo(gg.y), st.o[d][4 * i4 + 3] * inv * bfhi(gg.y));
            *(u32x2*)(op + 32 * d + 8 * i4) = w; }
}
__device__ __forceinline__ void mixM_phase(const bf16_t* __restrict__ P, const bf16_t* __restrict__ KVM, bf16_t* UM, int bg0, LAS char* lds, int tid, int vcu, int G) {
    const int lane = tid & 63, wave = __builtin_amdgcn_readfirstlane(tid >> 6), r = lane & 31, h = lane >> 5;
    for (int uid = vcu; uid < M_NU; uid += G) {
        const int b = uid >> 5, hh = (uid >> 3) & 3, part = uid & 7;
        const long qrow0 = (long)b * SEQ + part * 512 + (wave * 2) * 32 + r;
        bf16x8 qfa[8], qfb[8];
        { const bf16_t* qp = P + pidx(qrow0, C_MQ + hh * 128 + 8 * h); const bf16_t* qq = P + pidx(qrow0 + 32, C_MQ + hh * 128 + 8 * h);
#pragma unroll
          for (int s = 0; s < 8; ++s) { qfa[s] = *(const bf16x8*)(qp + 16 * s); qfb[s] = *(const bf16x8*)(qq + 16 * s); } }
        const bf16_t* Kb = KVM + (size_t)(bg0 + b) * NMEM * 1024 + hh * 128;
#pragma unroll
        for (int it = 0; it < 8; ++it) { const int idx = tid + 512 * it, row = idx >> 4, ch = idx & 15; const bf16_t* rp = Kb + (size_t)row * 1024 + ch * 8;
            const u32x4 kv = *(const u32x4*)rp, vv = *(const u32x4*)(rp + 512);
            *(LAS u32x4*)(lds + row * M_ROWB + ch * 16) = kv; *(LAS u32x4*)(lds + M_VOFF + row * M_ROWB + ch * 16) = vv; }
        __syncthreads();
        m_tile(P, UM, qrow0, hh, qfa, lds, lane);
        m_tile(P, UM, qrow0 + 32, hh, qfb, lds, lane);
        __syncthreads();
    }
}
}

constexpr size_t MiB = 1u << 20;
constexpr size_t WS_ROWSS = 0;
constexpr size_t WS_BAR = 512 * 1024;
constexpr size_t WS_COSA = 1 * MiB, WS_SINA = WS_COSA + 512 * 1024;
constexpr size_t WS_COSB = 2 * MiB, WS_SINB = WS_COSB + 4096;
constexpr size_t WS_MEMN = 3 * MiB;
constexpr size_t WS_KVM = 11 * MiB;
constexpr size_t WS_WIN = 19 * MiB;
constexpr size_t WS_WMEM = 40 * MiB;
constexpr size_t WS_WBR = 42 * MiB;
constexpr size_t WS_WOUT = 45 * MiB;
constexpr size_t WS_U = 52 * MiB;
constexpr size_t WS_Y = WS_U + (size_t)3 * RC * 512 * 2;
constexpr size_t WS_H = WS_Y;
constexpr size_t WS_OA = WS_Y + (size_t)RC * 1024 * 2;
constexpr size_t WS_LSE = WS_OA + (size_t)RC * 1536 * 2;
constexpr size_t WS_P = WS_Y + (size_t)RC * 3072 * 2;
constexpr size_t WS_END = WS_P + (size_t)RC * PITCH * 2;
static_assert(WS_LSE + (size_t)RC * 24 * 4 <= WS_P, "mixer A scratch fits under Y");
static_assert(WS_WOUT + (size_t)1024 * 3072 * 2 <= WS_U && WS_WIN + (size_t)INW * 1024 * 2 <= WS_WMEM, "weight map");
static_assert(pg8::EP_P == WS_P && pg8::EP_KVM == WS_KVM && pg8::EP_COSA == WS_COSA && pg8::EP_SINA == WS_SINA && pg8::EP_COSB == WS_COSB && pg8::EP_SINB == WS_SINB, "epilogue offsets match the map");
static_assert(WS_END <= (size_t)1024 * MiB, "workspace map exceeds 4x the largest tensor");

constexpr int LDS_BYTES = 147456, MISC_OFF = 147440;
constexpr int NTHREADS = 512, NWAVES = 8;

typedef __attribute__((address_space(1))) unsigned char* gptr_t;
template <class T> __device__ __forceinline__ T* as_global(T* p) { return (T*)(__attribute__((address_space(1))) T*)p; }
struct Args { const float *p0, *p1, *p2, *p3, *p4, *p5, *p6, *p7, *p8, *p9, *p10, *p11, *p12, *p13; float* out; unsigned char* ws; double invA[32]; double invB[16]; int ph_lo, ph_hi; };
enum { I_X = 0, I_MEM, I_GPRE, I_WIN, I_BMERGE, I_QN, I_KN, I_GMEM, I_WMEMKV, I_WBRA, I_WBRB, I_WBRM, I_WOUT, I_GPOST };

__device__ __forceinline__ int sigma_inv(int n) {
    const int t = n & 255; return (n & ~255) + 128 * ((t >> 5) & 1) + 32 * ((t >> 6) & 3) + 16 * ((t >> 2) & 1) + 4 * ((t >> 3) & 3) + (t & 3);
}
__device__ __forceinline__ int sigma_inv_g(int n) {
    const int t = n & 255; return (n & ~255) + 128 * ((t >> 3) & 1) + 32 * ((t >> 6) & 3) + 16 * ((t >> 2) & 1) + 4 * ((t >> 4) & 3) + (t & 3);
}
__device__ __forceinline__ void transpose_item(const float* __restrict__ W, int N, bf16_t* WT, int ldo, int rowoff, int koff, LAS float* scr, int item, int lane, int gfrom = 0x7fffffff) {
    const int nblk = N / 32, kb = item / nblk, nb = item % nblk, k0 = 64 * kb, n0 = 32 * nb;
#pragma unroll 8
    for (int i = 0; i < 32; ++i) { const int kk = 2 * i + (lane >> 5); scr[kk * 33 + (lane & 31)] = W[(size_t)(k0 + kk) * N + n0 + (lane & 31)]; }
    asm volatile("s_waitcnt lgkmcnt(0)" ::: "memory");
    const int c = lane & 7;
#pragma unroll
    for (int j = 0; j < 4; ++j) { const int n = (lane >> 3) + 8 * j; const LAS float* s = scr + (8 * c) * 33 + n;
        u32x4 o; o.x = pk2(s[0 * 33], s[1 * 33]); o.y = pk2(s[2 * 33], s[3 * 33]); o.z = pk2(s[4 * 33], s[5 * 33]); o.w = pk2(s[6 * 33], s[7 * 33]);
        const int nn = n0 + n; *(u32x4*)(WT + (size_t)(rowoff + (nn >= gfrom ? sigma_inv_g(nn) : sigma_inv(nn))) * ldo + koff + k0 + 8 * c) = o; }
    asm volatile("s_waitcnt lgkmcnt(0)" ::: "memory");
}
__device__ __forceinline__ float wave_sum(float v) {
#pragma unroll
    for (int o = 1; o < 64; o <<= 1) v += __shfl_xor(v, o);
    return v;
}
__device__ __forceinline__ void rms_row_to_bf16(const float* __restrict__ xrow, const float* __restrict__ g, bf16_t* orow, int lane) {
    const f32x4* xr = (const f32x4*)xrow + lane; const f32x4* gr = (const f32x4*)g + lane;
    f32x4 v[4]; float s = 0.f;
#pragma unroll
    for (int j = 0; j < 4; ++j) { v[j] = xr[64 * j]; s += (v[j].x * v[j].x + v[j].y * v[j].y) + (v[j].z * v[j].z + v[j].w * v[j].w); }
    const float rstd = rsqrtf(wave_sum(s) * (1.f / 1024.f) + NORM_EPS);
    u32x2* o8 = (u32x2*)orow + lane;
#pragma unroll
    for (int j = 0; j < 4; ++j) { const f32x4 gg = gr[64 * j]; u32x2 w; w.x = pk2(v[j].x * rstd * gg.x, v[j].y * rstd * gg.y); w.y = pk2(v[j].z * rstd * gg.z, v[j].w * rstd * gg.w); o8[64 * j] = w; }
}
__device__ __forceinline__ void sincos_d(double ang, float& c, float& s) {
    const double n = rint(ang * 0.63661977236758134308);
    double y = fma(-n, 1.5707963267948966, ang); y = fma(-n, 6.123233995736766e-17, y);
    const int q = ((int)n) & 3; const double y2 = y * y;
    const double sy = y + y * y2 * (-1.0 / 6 + y2 * (1.0 / 120 + y2 * (-1.0 / 5040 + y2 * (1.0 / 362880 + y2 * (-1.0 / 39916800 + y2 * (1.0 / 6227020800.0))))));
    const double cy = 1.0 + y2 * (-0.5 + y2 * (1.0 / 24 + y2 * (-1.0 / 720 + y2 * (1.0 / 40320 + y2 * (-1.0 / 3628800 + y2 * (1.0 / 479001600.0))))));
    const double cc = (q == 0) ? cy : (q == 1) ? -sy : (q == 2) ? -cy : sy;
    const double ss = (q == 0) ? sy : (q == 1) ? cy : (q == 2) ? -sy : -cy;
    c = (float)cc; s = (float)ss;
}

typedef __attribute__((address_space(1))) unsigned gu32;
#define XB_TMO      128
#define XB_XCNT(j)  (256  + 64 * (j))
#define XB_XSUB(j)  (1280 + 64 * (j))
#define XB_XGEN(j)  (2304 + 64 * (j))
#define XB_TOP      3328
#define XB_TOPGEN   3392
#define XCD_BAR_WORDS 3456
#define XB_SPIN_CAP (1u << 18)

__device__ __forceinline__ unsigned xb_ld(unsigned* p)              { return __hip_atomic_load(p, __ATOMIC_RELAXED, __HIP_MEMORY_SCOPE_AGENT); }
__device__ __forceinline__ unsigned xb_add(unsigned* p, unsigned v) { return __hip_atomic_fetch_add(p, v, __ATOMIC_RELAXED, __HIP_MEMORY_SCOPE_AGENT); }
__device__ __forceinline__ unsigned xb_xcc_id() { return (unsigned)__builtin_amdgcn_s_getreg((3 << 11) | 20) & 0xFu; }
#define XB_SPIN(cond, bar) do { unsigned _sp = 0; while (cond) { __builtin_amdgcn_s_sleep(1); \
    if ((++_sp & 255u) == 0u) { if (xb_ld(&(bar)[XB_TMO])) break; if (_sp > XB_SPIN_CAP) { atomicAdd(&(bar)[XB_TMO], 1u); break; } } } } while (0)

struct XcdBarrier {
    unsigned* bar; unsigned x;
    volatile LAS unsigned* st;
};

__device__ __forceinline__ XcdBarrier xcd_barrier_post(unsigned* bar, volatile LAS unsigned* st) {
    XcdBarrier b; b.bar = bar; b.x = xb_xcc_id(); b.st = st;
    if (threadIdx.x == 0) (void)xb_add(&bar[XB_XCNT(b.x)], 1u);
    return b;
}
__device__ __forceinline__ void xcd_barrier_complete(unsigned* bar, unsigned x, unsigned& nloc, unsigned& nx) {
    const unsigned G = gridDim.x * gridDim.y * gridDim.z;
    unsigned sum, cnt, mine, sp = 0u;
    for (;;) {
        sum = 0u; cnt = 0u; mine = 0u;
#pragma unroll
        for (unsigned j = 0; j < 16; ++j) { const unsigned c = xb_ld(&bar[XB_XCNT(j)]); sum += c; cnt += (c > 0u) ? 1u : 0u; mine = (j == x) ? c : mine; }
        if (sum == G) break;
        __builtin_amdgcn_s_sleep(1);
        if ((++sp & 255u) == 0u) { if (xb_ld(&bar[XB_TMO])) break; if (sp > XB_SPIN_CAP) { atomicAdd(&bar[XB_TMO], 1u); break; } }
    }
    nloc = mine > 0u ? mine : 1u; nx = cnt > 0u ? cnt : 1u;
}

__device__ __forceinline__ void xcd_barrier(const XcdBarrier& b) {
    asm volatile("s_waitcnt vmcnt(0)" ::: "memory");
    __syncthreads();
    if (threadIdx.x == 0) {
        unsigned* bar = b.bar;
        __builtin_amdgcn_s_waitcnt(0);
        unsigned nloc = b.st[0], nx = b.st[1];
        if (nloc == 0u) { xcd_barrier_complete(bar, b.x, nloc, nx); b.st[0] = nloc; b.st[1] = nx; }
        const unsigned old = xb_add(&bar[XB_XSUB(b.x)], 1u);
        const unsigned gen = old / nloc;
        if (old + 1u == (gen + 1u) * nloc) {
            __builtin_amdgcn_fence(__ATOMIC_RELEASE, "agent");
            asm volatile("s_waitcnt vmcnt(0)" ::: "memory");
            const unsigned og = xb_add(&bar[XB_TOP], 1u);
            const unsigned tg = og / nx;
            if (og + 1u == (tg + 1u) * nx) xb_add(&bar[XB_TOPGEN], 1u);
            else XB_SPIN(xb_ld(&bar[XB_TOPGEN]) == tg, bar);
            __builtin_amdgcn_fence(__ATOMIC_ACQUIRE, "agent");
            xb_add(&bar[XB_XGEN(b.x)], 1u);
            asm volatile("s_waitcnt vmcnt(0)" ::: "memory");
        } else {
            XB_SPIN(xb_ld(&bar[XB_XGEN(b.x)]) == gen, bar);
            __builtin_amdgcn_fence(__ATOMIC_ACQUIRE, "agent");
            asm volatile("s_waitcnt vmcnt(0)" ::: "memory");
        }
    }
    __syncthreads();
}

__global__ void __launch_bounds__(NTHREADS, 2) mega_fwd(Args a) {
    extern __shared__ __attribute__((aligned(16))) unsigned char lds[];
    cg::grid_group grid = cg::this_grid();
    unsigned* const barw = (unsigned*)(a.ws + WS_BAR);
    { LAS unsigned* misc = (LAS unsigned*)((LAS unsigned char*)lds + MISC_OFF); if (threadIdx.x < 4) misc[threadIdx.x] = 0u;
      if (blockIdx.x == 0) for (int i = threadIdx.x; i < XCD_BAR_WORDS; i += NTHREADS) barw[i] = 0u;
      __syncthreads(); }
    XcdBarrier xb; xb.bar = barw; xb.x = 0; xb.st = nullptr;
#define IN(k) true
#define SEAM(k) do { gptr_t b_ = (gptr_t)a.ws; asm volatile("" : "+s"(b_)); xb.bar = (unsigned*)((unsigned char*)b_ + WS_BAR); xcd_barrier(xb); } while (0)
#define PHASE_VARS() \
    int tid = threadIdx.x; asm volatile("" : "+v"(tid)); gptr_t wsg_ = (gptr_t)a.ws; asm volatile("" : "+s"(wsg_)); unsigned char* ws = (unsigned char*)wsg_; const float* const in_[14] = {a.p0, a.p1, a.p2, a.p3, a.p4, a.p5, a.p6, a.p7, a.p8, a.p9, a.p10, a.p11, a.p12, a.p13}; (void)in_; \
    const int lane = tid & 63, wave = __builtin_amdgcn_readfirstlane(tid >> 6); \
    const int G = gridDim.x, bx = blockIdx.x, vcu = (G % 8 == 0) ? (bx % 8) * (G / 8) + bx / 8 : bx; \
    const int gw = vcu * NWAVES + wave, NGW = G * NWAVES; (void)gw; (void)NGW; (void)lane; (void)vcu; \
    LAS unsigned char* ldsl = (LAS unsigned char*)lds; (void)ldsl

    if (IN(0)) {
        PHASE_VARS();
        float* rowss = (float*)(ws + WS_ROWSS);
        float* cosA = (float*)(ws + WS_COSA); float* sinA = (float*)(ws + WS_SINA); float* cosB = (float*)(ws + WS_COSB); float* sinB = (float*)(ws + WS_SINB);
        bf16_t* MEMN = (bf16_t*)(ws + WS_MEMN); bf16_t* WIN = (bf16_t*)(ws + WS_WIN); bf16_t* WMEM = (bf16_t*)(ws + WS_WMEM); bf16_t* WBR = (bf16_t*)(ws + WS_WBR); bf16_t* WOUT = (bf16_t*)(ws + WS_WOUT);
        bf16_t* H = (bf16_t*)(ws + WS_H);
        LAS float* scr = (LAS float*)(ldsl + wave * 16384);
        constexpr int I_IN = (1024 / 64) * (INW / 32), I_MK = (1024 / 64) * (1024 / 32), I_BR = (512 / 64) * (1024 / 32), I_O = (1024 / 64) * (1024 / 32);
        constexpr int NITEMS = I_IN + I_MK + 3 * I_BR + I_O;
        for (int it = gw; it < NITEMS; it += NGW) {
            int r = it;
            if (r < I_IN) { transpose_item(in_[I_WIN], INW, WIN, 1024, 0, 0, scr, r, lane); continue; } r -= I_IN;
            if (r < I_MK) { transpose_item(in_[I_WMEMKV], 1024, WMEM, 1024, 0, 0, scr, r, lane); continue; } r -= I_MK;
            if (r < I_BR) { transpose_item(in_[I_WBRA], 1024, WBR, 512, 0, 0, scr, r, lane); continue; } r -= I_BR;
            if (r < I_BR) { transpose_item(in_[I_WBRB], 1024, WBR, 512, 1024, 0, scr, r, lane); continue; } r -= I_BR;
            if (r < I_BR) { transpose_item(in_[I_WBRM], 1024, WBR, 512, 2048, 0, scr, r, lane); continue; } r -= I_BR;
            transpose_item(in_[I_WOUT], 1024, WOUT, 1024, 0, 0, scr, r, lane);
        }
        for (int i = bx * NTHREADS + tid; i < SEQ * 32; i += G * NTHREADS) { float c, s; sincos_d((double)(i >> 5) * a.invA[i & 31], c, s); cosA[i] = c; sinA[i] = s; }
        for (int i = bx * NTHREADS + tid; i < 64 * 16; i += G * NTHREADS) { float c, s; sincos_d((double)(i >> 4) * a.invB[i & 15], c, s); cosB[i] = c; sinB[i] = s; }
        for (int i = bx * NTHREADS + tid; i < MTOT; i += G * NTHREADS) rowss[i] = 0.f;
        for (int m = gw; m < BATCH * NMEM; m += NGW) rms_row_to_bf16(in_[I_MEM] + (size_t)m * 1024, in_[I_GMEM], MEMN + (size_t)m * 1024, lane);
        for (int m = gw; m < RC; m += NGW) rms_row_to_bf16(in_[I_X] + (size_t)m * 1024, in_[I_GPRE], H + (size_t)m * 1024, lane);
    }
    grid.sync();
    xb = xcd_barrier_post(barw, (volatile LAS unsigned*)((LAS unsigned char*)lds + MISC_OFF));

    for (int c = 0; c < NCH; ++c) {
        const int pb = 1 + 6 * c;
        const size_t grow0 = (size_t)c * RC;

        if (IN(pb)) {
            PHASE_VARS();
            pg8::Sched S; S.nM = RC / 256; S.nN = INW / 256; S.nwg = S.nM * S.nN; S.nX = (c == 0) ? (BATCH * NMEM / 256) * 4 : 0; S.G = G; S.c = bx; S.seg3 = 0;
            S.A = (const char*)(ws + WS_H); S.B = (const char*)(ws + WS_WIN); S.A2 = (const char*)(ws + WS_MEMN); S.B2 = (const char*)(ws + WS_WMEM); S.tsA = (size_t)256 * 1024 * 2; S.tsB = (size_t)256 * 1024 * 2; S.grpStride = 0; S.grpShift = 31;
            pg8::EpiP1 E{ws, in_[I_BMERGE], in_[I_QN], in_[I_KN]};
            pg8::gemm_phase<pg8::EpiP1, pg8::Sched, true, true>(ldsl, 1024, S, E);
        }
        SEAM(pb);

        if (IN(pb + 1)) {
            PHASE_VARS();
            const bf16_t* P = (const bf16_t*)(ws + WS_P); bf16_t* U = (bf16_t*)(ws + WS_U); bf16_t* OA = (bf16_t*)(ws + WS_OA); float* LSE = (float*)(ws + WS_LSE);
            const int rcls = vcu & 3; int nb = 0, uid = vcu;
            for (; uid < BPC * 8 * 16 && nb < rcls; uid += G, ++nb) {
                const int pair = uid >> 6, sub = uid & 63, b = pair >> 1, h = (pair & 1) * 4 + (sub >> 4), qb = sub & 15;
                attn_body::attn_unit<8>((long)b * SEQ, h, qb, (const attn_body::bf16*)P, (attn_body::bf16*)(U + (size_t)RC * 512), (char*)lds);
            }
            __syncthreads();
            wa::mixA_phase(P, OA, LSE, (LAS char*)ldsl, tid, vcu, G);
            for (; uid < BPC * 8 * 16; uid += G) {
                const int pair = uid >> 6, sub = uid & 63, b = pair >> 1, h = (pair & 1) * 4 + (sub >> 4), qb = sub & 15;
                attn_body::attn_unit<8>((long)b * SEQ, h, qb, (const attn_body::bf16*)P, (attn_body::bf16*)(U + (size_t)RC * 512), (char*)lds);
            }
            __syncthreads();
        }
        if (IN(pb + 1)) {
            PHASE_VARS();
            const bf16_t* P = (const bf16_t*)(ws + WS_P); bf16_t* U = (bf16_t*)(ws + WS_U); const bf16_t* KVM = (const bf16_t*)(ws + WS_KVM);
            wa::mixM_phase(P, KVM, U + (size_t)2 * RC * 512, c * BPC, (LAS char*)ldsl, tid, vcu, G);
        }
        SEAM(pb + 1);
        if (IN(pb + 2)) {
            PHASE_VARS();
            const bf16_t* P = (const bf16_t*)(ws + WS_P); bf16_t* U = (bf16_t*)(ws + WS_U); const bf16_t* OA = (const bf16_t*)(ws + WS_OA); const float* LSE = (const float*)(ws + WS_LSE);
            for (int idx = bx * NTHREADS + tid; idx < RC * 64; idx += G * NTHREADS) {
                const int row = idx >> 6, c8 = idx & 63, hh = c8 >> 3;
                const float l0 = LSE[(size_t)row * 24 + hh], l1 = LSE[(size_t)row * 24 + 8 + hh], l2 = LSE[(size_t)row * 24 + 16 + hh];
                const float mx = fmaxf(l0, fmaxf(l1, l2));
                float w0 = __builtin_amdgcn_exp2f(l0 - mx), w1 = __builtin_amdgcn_exp2f(l1 - mx), w2 = __builtin_amdgcn_exp2f(l2 - mx);
                const float inv = 1.f / (w0 + w1 + w2); w0 *= inv; w1 *= inv; w2 *= inv;
                const bf16_t* op = OA + (size_t)row * 1536 + c8 * 8;
                const u32x4 o0 = *(const u32x4*)op, o1 = *(const u32x4*)(op + 512), o2 = *(const u32x4*)(op + 1024), gt = *(const u32x4*)(P + pidx(row, C_GA + c8 * 8));
                u32x4 w;
#pragma unroll
                for (int e = 0; e < 4; ++e) { const float vlo = (w0 * bflo(o0[e]) + w1 * bflo(o1[e]) + w2 * bflo(o2[e])) * bflo(gt[e]), vhi = (w0 * bfhi(o0[e]) + w1 * bfhi(o1[e]) + w2 * bfhi(o2[e])) * bfhi(gt[e]); w[e] = pk2(vlo, vhi); }
                *(u32x4*)(U + (size_t)row * 512 + c8 * 8) = w;
            }
        }
        SEAM(pb + 2);

        if (IN(pb + 3)) {
            PHASE_VARS();
            pg8::Sched S; S.nM = RC / 256; S.nN = 4; S.nwg = S.nM * S.nN; S.nX = 0; S.G = G; S.c = bx; S.seg3 = 1;
            S.A = (const char*)(ws + WS_U); S.B = (const char*)(ws + WS_WBR); S.A2 = S.A; S.B2 = S.B; S.tsA = (size_t)256 * 512 * 2; S.tsB = (size_t)256 * 512 * 2; S.grpStride = (size_t)RC * 512 * 2; S.grpShift = 2;
            pg8::EpiBr E{(const bf16_t*)(ws + WS_P), (bf16_t*)(ws + WS_Y)};
            pg8::gemm_phase<pg8::EpiBr, pg8::Sched, true, true>(ldsl, 512, S, E);
        }
        SEAM(pb + 3);

        if (IN(pb + 4)) {
            PHASE_VARS();
            pg8::Sched S; S.nM = RC / 256; S.nN = 4; S.nwg = S.nM * S.nN; S.nX = 0; S.G = G; S.c = bx; S.seg3 = 0;
            S.A = (const char*)(ws + WS_Y); S.B = (const char*)(ws + WS_WOUT); S.A2 = S.A; S.B2 = S.B; S.tsA = (size_t)256 * 1024 * 2; S.tsB = (size_t)256 * 1024 * 2; S.grpStride = 0; S.grpShift = 31;
            pg8::EpiOut E{a.out + grow0 * 1024, (float*)(ws + WS_ROWSS) + grow0};
            pg8::gemm_phase<pg8::EpiOut, pg8::Sched, true, true>(ldsl, 1024, S, E);
        }
        SEAM(pb + 4);

        if (IN(pb + 5)) {
            PHASE_VARS();
            const float* gpost = in_[I_GPOST]; const float* rowss = (const float*)(ws + WS_ROWSS); bf16_t* H = (bf16_t*)(ws + WS_H);
            for (int m = gw; m < RC; m += NGW) {
                const size_t row = grow0 + m; const float rstd = rsqrtf(rowss[row] * (1.f / 1024.f) + NORM_EPS);
                const f32x4* xr = (const f32x4*)(in_[I_X] + row * 1024) + lane; f32x4* orp = (f32x4*)(a.out + row * 1024) + lane; const f32x4* gr = (const f32x4*)gpost + lane;
                const u32x2* pr = (const u32x2*)(a.out + row * 1024) + lane;
                u32x2 pv[4];
#pragma unroll
                for (int j = 0; j < 4; ++j) pv[j] = __builtin_nontemporal_load(pr + 64 * j);
                asm volatile("s_waitcnt vmcnt(0)" ::: "memory");
#pragma unroll
                for (int j = 0; j < 4; ++j) { const f32x4 o = {bflo(pv[j].x), bfhi(pv[j].x), bflo(pv[j].y), bfhi(pv[j].y)}; __builtin_nontemporal_store(__builtin_nontemporal_load(xr + 64 * j) + o * rstd * gr[64 * j], orp + 64 * j); }
            }
            if (c + 1 < NCH) for (int m = gw; m < RC; m += NGW) rms_row_to_bf16(in_[I_X] + (grow0 + RC + m) * 1024, in_[I_GPRE], H + (size_t)m * 1024, lane);
        }
        if (c + 1 < NCH) SEAM(pb + 5);
    }
#undef IN
#undef SEAM
#undef PHASE_VARS
}

constexpr int N_PHASES = 1 + 6 * NCH;
extern "C" void kernel_launch(void* const* d_in, const int* in_sizes, int n_in, void* d_out, int out_size, void* d_ws, size_t ws_size, hipStream_t stream) {
    static int grid = 0;
    if (grid == 0) {
        if (n_in != 14 || in_sizes[0] != MTOT * 1024 || out_size != MTOT * 1024 || ws_size < WS_END) { fprintf(stderr, "kernel_launch: unexpected shapes (n_in %d, ws %zu, need %zu); nothing launched\n", n_in, ws_size, (size_t)WS_END); grid = -1; return; }
        int dev = 0, cus = 0, per_cu = 0;
        (void)hipGetDevice(&dev); (void)hipDeviceGetAttribute(&cus, hipDeviceAttributeMultiprocessorCount, dev);
        if (hipFuncSetAttribute((const void*)mega_fwd, hipFuncAttributeMaxDynamicSharedMemorySize, LDS_BYTES) != hipSuccess) { fprintf(stderr, "kernel_launch: hipFuncSetAttribute failed\n"); grid = -1; return; }
        if (hipOccupancyMaxActiveBlocksPerMultiprocessor(&per_cu, (const void*)mega_fwd, NTHREADS, LDS_BYTES) != hipSuccess || per_cu < 1) { fprintf(stderr, "kernel_launch: occupancy query reports %d\n", per_cu); per_cu = 1; }
        (void)hipGetLastError();
        grid = cus;
        if (grid > cus * per_cu) grid = cus * per_cu;
    }
    if (grid < 0) return;
    Args a{};
    { const float** pp = &a.p0; for (int i = 0; i < 14; ++i) pp[i] = (const float*)d_in[i]; }
    a.out = (float*)d_out; a.ws = (unsigned char*)d_ws;
    for (int i = 0; i < 32; ++i) a.invA[i] = pow(10000.0, -(double)i / 32.0);
    for (int i = 0; i < 16; ++i) a.invB[i] = pow(10000.0, -(double)i / 16.0);
    a.ph_lo = 0; a.ph_hi = N_PHASES;
    void* args[] = {&a};
    hipError_t e = hipLaunchCooperativeKernel((const void*)mega_fwd, dim3(grid), dim3(NTHREADS), args, LDS_BYTES, stream);
    if (e != hipSuccess) fprintf(stderr, "cooperative launch failed: %s (grid %d)\n", hipGetErrorString(e), grid);
}
```
